# Optimizing an MI355X kernel written in HIP

```python
import math
import jax, jax.numpy as jnp
from jax import lax
import numpy as np

D_MODEL = 1024
BATCH = 16
SEQ = 4096
DEPTH = 1

HEAD_DIM = 64
N_MOBA_HEADS = 8
N_FOX_HEADS = 8
MOBA_WIDTH = N_MOBA_HEADS * HEAD_DIM
FOX_WIDTH = N_FOX_HEADS * HEAD_DIM
MOBA_BLOCK = 256
MOBA_TOPK = 3
Q_CHUNK = 128
ROPE_THETA = 500000.0
ROPE_DIM = HEAD_DIM // 4
D_FF = 11 * D_MODEL // 4
CONV_WIDTH = 3
NORM_EPS = 1e-6
N_BRANCH = 2
NEG_INF = -1e30
IN_SPLITS = (MOBA_WIDTH, MOBA_WIDTH, MOBA_WIDTH, FOX_WIDTH, FOX_WIDTH, FOX_WIDTH, N_FOX_HEADS, N_BRANCH * D_MODEL)
IN_COLS = sum(IN_SPLITS)

kernel_name = "hybrid_moba_fox_gated_convffn"


def rms_norm(x, g):
    xf = x.astype(jnp.float32)
    y = xf * lax.rsqrt(jnp.mean(xf * xf, axis=-1, keepdims=True) + NORM_EPS)
    return (y * g.astype(jnp.float32)).astype(x.dtype)


def split_heads(t, n_heads):
    b, s, _ = t.shape
    return t.reshape(b, s, n_heads, HEAD_DIM).transpose(0, 2, 1, 3)


def merge_heads(t):
    b, h, s, d = t.shape
    return t.transpose(0, 2, 1, 3).reshape(b, s, h * d)


def partial_rope(x, pos):
    half = ROPE_DIM // 2
    inv_freq = jnp.power(ROPE_THETA, -jnp.arange(half, dtype=jnp.float32) * 2.0 / ROPE_DIM)
    ang = pos.astype(jnp.float32)[:, None] * inv_freq[None, :]
    cos, sin = jnp.cos(ang), jnp.sin(ang)
    xr = x[..., :ROPE_DIM].astype(jnp.float32)
    x1, x2 = xr[..., :half], xr[..., half:]
    rot = jnp.concatenate([x1 * cos - x2 * sin, x2 * cos + x1 * sin], axis=-1).astype(x.dtype)
    return jnp.concatenate([rot, x[..., ROPE_DIM:]], axis=-1)


def moba_attention(q, k, v):
    B, H, S, Dh = q.shape
    nb = -(-S // MOBA_BLOCK)
    pad = nb * MOBA_BLOCK - S
    nqc = S // Q_CHUNK
    scale = Dh ** -0.5
    kp = jnp.pad(k, ((0, 0), (0, 0), (0, pad), (0, 0)))
    vp = jnp.pad(v, ((0, 0), (0, 0), (0, pad), (0, 0)))
    kb = kp.reshape(B, H, nb, MOBA_BLOCK, Dh)
    vb = vp.reshape(B, H, nb, MOBA_BLOCK, Dh)
    k_mean = jnp.mean(kb, axis=3, dtype=jnp.float32)
    gate = jnp.einsum('bhsd,bhnd->bhsn', q.astype(jnp.float32), k_mean)
    pos = jnp.arange(S)
    q_blk = pos // MOBA_BLOCK
    fully_past = jnp.arange(nb)[None, :] < q_blk[:, None]
    gate = jnp.where(fully_past, gate, -jnp.inf)
    k_sel = min(MOBA_TOPK, nb)
    top_val, top_idx = lax.top_k(gate, k_sel)
    top_ok = jnp.isfinite(top_val)
    own = jnp.broadcast_to(q_blk[None, None, :, None], (B, H, S, 1)).astype(top_idx.dtype)
    sel_idx = jnp.concatenate([top_idx, own], axis=-1)
    sel_ok = jnp.concatenate([top_ok, jnp.ones((B, H, S, 1), dtype=bool)], axis=-1)
    ns = k_sel + 1

    def to_chunks(t):
        tail = t.shape[3:]
        t = t.reshape((B, H, nqc, Q_CHUNK) + tail)
        t = jnp.moveaxis(t, 2, 1)
        return t.reshape((B * nqc, H, Q_CHUNK) + tail)

    q_c = to_chunks(q)
    idx_c = to_chunks(sel_idx)
    ok_c = to_chunks(sel_ok)
    b_ids = jnp.repeat(jnp.arange(B), nqc)
    qpos_c = jnp.tile(pos.reshape(nqc, Q_CHUNK), (B, 1))
    head_ix = jnp.arange(H)[:, None, None]
    key_off = jnp.arange(MOBA_BLOCK)

    def step(args):
        b, qi, idx, ok, qp = args
        k_g = kb[b][head_ix, idx]
        v_g = vb[b][head_ix, idx]
        s = jnp.einsum('hcd,hcnld->hcnl', qi, k_g, preferred_element_type=jnp.float32) * scale
        kpos = idx[..., None] * MOBA_BLOCK + key_off
        mask = ok[..., None] & (kpos <= qp[None, :, None, None])
        s = jnp.where(mask, s, NEG_INF)
        p = jax.nn.softmax(s.reshape(H, Q_CHUNK, ns * MOBA_BLOCK), axis=-1)
        p = p.reshape(H, Q_CHUNK, ns, MOBA_BLOCK).astype(v_g.dtype)
        o = jnp.einsum('hcnl,hcnld->hcd', p, v_g, preferred_element_type=jnp.float32)
        return o.astype(qi.dtype)

    out = lax.map(step, (b_ids, q_c, idx_c, ok_c, qpos_c))
    out = out.reshape(B, nqc, H, Q_CHUNK, Dh)
    return jnp.moveaxis(out, 1, 2).reshape(B, H, S, Dh)


def forgetting_attention(q, k, v, log_f):
    B, H, S, Dh = q.shape
    nqc = S // Q_CHUNK
    scale = Dh ** -0.5
    c = jnp.cumsum(log_f, axis=-1)
    pos = jnp.arange(S)
    q_c = jnp.moveaxis(q.reshape(B, H, nqc, Q_CHUNK, Dh), 2, 0)
    c_c = jnp.moveaxis(c.reshape(B, H, nqc, Q_CHUNK), 2, 0)
    qpos_c = pos.reshape(nqc, Q_CHUNK)

    def step(args):
        qi, ci, qp = args
        s = jnp.einsum('bhcd,bhsd->bhcs', qi, k, preferred_element_type=jnp.float32) * scale
        s = s + ci[..., None] - c[:, :, None, :]
        s = jnp.where(pos[None, :] <= qp[:, None], s, NEG_INF)
        p = jax.nn.softmax(s, axis=-1).astype(v.dtype)
        o = jnp.einsum('bhcs,bhsd->bhcd', p, v, preferred_element_type=jnp.float32)
        return o.astype(qi.dtype)

    out = lax.map(step, (q_c, c_c, qpos_c))
    return jnp.moveaxis(out, 0, 2).reshape(B, H, S, Dh)


def causal_depthwise_conv(t, w, bias):
    kern = w.reshape(CONV_WIDTH, 1, w.shape[-1]).astype(t.dtype)
    y = lax.conv_general_dilated(t, kern, window_strides=(1,), padding=[(CONV_WIDTH - 1, 0)],
                                 dimension_numbers=('NWC', 'WIO', 'NWC'),
                                 feature_group_count=t.shape[-1])
    return y + bias.astype(t.dtype)


def setup_inputs(seed: int = 0) -> dict:
    key = jax.random.key(seed)
    ks = jax.random.split(key, 18)
    f32 = jnp.float32

    def nrm(k, shape, scale):
        return jax.random.normal(k, shape, f32) * scale

    def gain(k, shape):
        return 1.0 + 0.02 * jax.random.normal(k, shape, f32)

    return {
        "x": nrm(ks[0], (BATCH, SEQ, D_MODEL), 1.0),
        "attn_norm_g": gain(ks[1], (DEPTH, D_MODEL)),
        "w_in": nrm(ks[2], (DEPTH, D_MODEL, IN_COLS), D_MODEL ** -0.5),
        "b_forget": nrm(ks[3], (DEPTH, N_FOX_HEADS), 0.1),
        "b_gate": nrm(ks[4], (DEPTH, N_BRANCH, D_MODEL), 0.1),
        "moba_q_norm_g": gain(ks[5], (DEPTH, HEAD_DIM)),
        "moba_k_norm_g": gain(ks[6], (DEPTH, HEAD_DIM)),
        "fox_q_norm_g": gain(ks[7], (DEPTH, HEAD_DIM)),
        "fox_k_norm_g": gain(ks[8], (DEPTH, HEAD_DIM)),
        "w_branch_moba": nrm(ks[9], (DEPTH, MOBA_WIDTH, D_MODEL), MOBA_WIDTH ** -0.5),
        "w_branch_fox": nrm(ks[10], (DEPTH, FOX_WIDTH, D_MODEL), FOX_WIDTH ** -0.5),
        "w_out": nrm(ks[11], (DEPTH, D_MODEL, D_MODEL), D_MODEL ** -0.5),
        "ffn_norm_g": gain(ks[12], (DEPTH, D_MODEL)),
        "w_ffn_up": nrm(ks[13], (DEPTH, D_MODEL, 2 * D_FF), D_MODEL ** -0.5),
        "ffn_conv_w": nrm(ks[14], (DEPTH, CONV_WIDTH, D_FF), CONV_WIDTH ** -0.5),
        "ffn_conv_b": nrm(ks[15], (DEPTH, D_FF), 0.02),
        "w_ffn_down": nrm(ks[16], (DEPTH, D_FF, D_MODEL), D_FF ** -0.5),
    }


def reference(x, attn_norm_g, w_in, b_forget, b_gate, moba_q_norm_g, moba_k_norm_g,
              fox_q_norm_g, fox_k_norm_g, w_branch_moba, w_branch_fox, w_out,
              ffn_norm_g, w_ffn_up, ffn_conv_w, ffn_conv_b, w_ffn_down):
    B, S, D = x.shape
    pos = jnp.arange(S)
    bounds = []
    acc = 0
    for w in IN_SPLITS[:-1]:
        acc += w
        bounds.append(acc)
    for l in range(DEPTH):
        h = rms_norm(x, attn_norm_g[l])
        proj = jnp.einsum('bsd,de->bse', h, w_in[l])
        qa, ka, va, qb, kb, vb, f_logit, g_logit = jnp.split(proj, bounds, axis=-1)
        qa = partial_rope(rms_norm(split_heads(qa, N_MOBA_HEADS), moba_q_norm_g[l]), pos)
        ka = partial_rope(rms_norm(split_heads(ka, N_MOBA_HEADS), moba_k_norm_g[l]), pos)
        va = split_heads(va, N_MOBA_HEADS)
        o_a = merge_heads(moba_attention(qa, ka, va))
        qb = rms_norm(split_heads(qb, N_FOX_HEADS), fox_q_norm_g[l])
        kb = rms_norm(split_heads(kb, N_FOX_HEADS), fox_k_norm_g[l])
        vb = split_heads(vb, N_FOX_HEADS)
        log_f = jax.nn.log_sigmoid(f_logit.astype(jnp.float32) + b_forget[l].astype(jnp.float32))
        log_f = log_f.transpose(0, 2, 1)
        o_b = merge_heads(forgetting_attention(qb, kb, vb, log_f))
        br_a = jnp.einsum('bse,ed->bsd', o_a, w_branch_moba[l])
        br_b = jnp.einsum('bse,ed->bsd', o_b, w_branch_fox[l])
        gates = jax.nn.sigmoid(g_logit.astype(jnp.float32).reshape(B, S, N_BRANCH, D)
                               + b_gate[l].astype(jnp.float32)).astype(x.dtype)
        merged = gates[:, :, 0] * br_a + gates[:, :, 1] * br_b
        x = x + jnp.einsum('bsd,de->bse', merged, w_out[l])
        h2 = rms_norm(x, ffn_norm_g[l])
        up = jnp.einsum('bsd,df->bsf', h2, w_ffn_up[l])
        u, g = jnp.split(up, 2, axis=-1)
        g = causal_depthwise_conv(g, ffn_conv_w[l], ffn_conv_b[l])
        x = x + jnp.einsum('bsf,fd->bsd', jax.nn.silu(g) * u, w_ffn_down[l])
    return x
```

```cpp
#include <hip/hip_runtime.h>
#include <hip/hip_cooperative_groups.h>
#include <cstdio>
#include <cstdint>
namespace cg = cooperative_groups;
constexpr int TOK = 65536, SEQ = 4096, DM = 1024, DFF = 2816, NCOL_IN = 5128;
constexpr float LOG2E = 1.4426950408889634f;
constexpr float QSCALE = 0.125f * 1.4426950408889634f;
constexpr float NORM_EPS = 1e-6f;
namespace pg8 {
#define PG8_LAS __attribute__((address_space(3)))
typedef unsigned short bf16_t;
typedef short bf16x8 __attribute__((ext_vector_type(8)));
typedef float f32x4 __attribute__((ext_vector_type(4)));
typedef unsigned u32x4 __attribute__((ext_vector_type(4)));
constexpr int BM = 256, BK = 64, HALF = 128, HTB = HALF * BK * 2  , STAGE_BYTES = 8 * HTB, NXCD = 8, WGM = 8;

__host__ __device__ __forceinline__ int lds_byte(int r, int c) { const int st = (r >> 4) * 2 + (c >> 5), rr = r & 15, cc = c & 31, ob = rr * 64 + cc * 2; return st * 1024 + (ob ^ (((ob >> 9) & 1) << 5)); }
__host__ __device__ __forceinline__ void stage_rc(int b, int& R, int& C) { const int st = b / 1024, sb = b % 1024, swz = sb ^ (((sb >> 9) & 1) << 5); R = (st >> 1) * 16 + swz / 64; C = (st & 1) * 32 + (swz % 64) / 2; }
__host__ __device__ __forceinline__ int perm32(int rho) { const int n = rho >> 4, i = rho & 15; return 8 * (i >> 2) + 4 * n + (i & 3); }

struct Unit { int pm, pn; };
struct Gemm { const bf16_t* A; const bf16_t* Bt; int M, N, K; };

struct StaticOrder {
    int nM, nN, nwg, G, c;
    __host__ __device__ void init(int M, int N, int G_, int c_) { nM = M / BM; nN = N / BM; nwg = nM * nN; G = G_; c = c_; }
    __host__ __device__ bool next(int i, Unit& u) const {
        const long L = (long)i * G + c; if (L >= nwg) return false;
        int wgid = (int)L; { const int q = nwg / NXCD, r = nwg % NXCD, xcd = wgid % NXCD, off = wgid / NXCD; wgid = (xcd < r ? xcd * (q + 1) : r * (q + 1) + (xcd - r) * q) + off; }
        const int nig = WGM * nN, gid = wgid / nig, fm = gid * WGM, gsz = (nM - fm) < WGM ? (nM - fm) : WGM;
        u.pm = fm + ((wgid % nig) % gsz); u.pn = (wgid % nig) / gsz; return true;
    }
    __device__ __forceinline__ void a_ready(const Unit&) const {}
    __device__ __forceinline__ void done(const Unit&) const {}
};

typedef float f32x2_t __attribute__((ext_vector_type(2))); typedef __bf16 bf16x2_t __attribute__((ext_vector_type(2)));
__device__ __forceinline__ unsigned cvt_pk_bf16(float lo, float hi) { f32x2_t v = {lo, hi}; bf16x2_t b = __builtin_convertvector(v, bf16x2_t); return __builtin_bit_cast(unsigned, b); }
__device__ __forceinline__ float sigm(float z) { return __builtin_amdgcn_rcpf(1.f + __builtin_amdgcn_exp2f(-z * LOG2E)); }
__device__ __forceinline__ float bflo(unsigned w) { return __uint_as_float(w << 16); }
__device__ __forceinline__ float bfhi(unsigned w) { return __uint_as_float(w & 0xffff0000u); }
#define PG8_EPI_BAR() asm volatile("s_waitcnt lgkmcnt(0)\n\ts_barrier" ::: "memory")

struct EpiG1 {
    static constexpr bool PERM = true, AFTER_DRAIN = false, MID = false;
    bf16_t *QKV, *GATES; float* KMP;
    int pn_base; float us;
    const float *gains, *bgate, *rope;
    __device__ __forceinline__ void mid(f32x4 (&acc)[2][2][4][2], const Unit& u, int wr, int wc, int fr, int fq) const {}
    __device__ __forceinline__ void operator()(f32x4 (&acc)[2][2][4][2], const Unit& u, int wr, int wc, int fr, int fq) const {
        int pn = pn_base == 0 ? (u.pn < 2 ? u.pn : u.pn + 4) : (u.pn < 4 ? u.pn + 2 : u.pn + 8), pm = u.pm;
        int rowt = pm * BM + wr * 64 + fr; asm volatile("" : "+v"(rowt));
        if (pn >= 12) {
            const int t = pn - 12, colb = t * 128 + wc * 32 + 8 * fq;
            const int gtid = (wr * 4 + wc) * 64 + fq * 16 + fr;
            f32x4 bv[2][2];
#pragma unroll
            for (int bj = 0; bj < 2; ++bj)
#pragma unroll
                for (int n = 0; n < 2; ++n) bv[bj][n] = *(const f32x4*)(bgate + bj * 1024 + colb + 4 * n);
#pragma unroll
            for (int ai = 0; ai < 2; ++ai)
#pragma unroll
                for (int m = 0; m < 4; ++m) { bf16_t* rowp = GATES + ((((size_t)(pm * 8 + t) * 8 + (ai * 4 + m)) * 512 + gtid) * 8);
                    f32x4 rr[2], gg[2];
#pragma unroll
                    for (int n = 0; n < 2; ++n) { const f32x4 z0 = acc[ai][0][m][n] * us + bv[0][n], z1 = acc[ai][1][m][n] * us + bv[1][n];
#pragma unroll
                        for (int e = 0; e < 4; ++e) { const float e0 = fminf(__builtin_amdgcn_exp2f(-z0[e] * LOG2E), 1e30f), e1 = fminf(__builtin_amdgcn_exp2f(-z1[e] * LOG2E), 1e30f);
                            gg[n][e] = __builtin_amdgcn_rcpf(1.f + e1); rr[n][e] = (1.f + e1) * __builtin_amdgcn_rcpf(1.f + e0); } }
                    u32x4 w; w.x = cvt_pk_bf16(rr[0][0], rr[0][1]); w.y = cvt_pk_bf16(rr[0][2], rr[0][3]); w.z = cvt_pk_bf16(rr[1][0], rr[1][1]); w.w = cvt_pk_bf16(rr[1][2], rr[1][3]);
                    *(u32x4*)rowp = w;
                    u32x4 v; v.x = cvt_pk_bf16(gg[0][0], gg[0][1]); v.y = cvt_pk_bf16(gg[0][2], gg[0][3]); v.z = cvt_pk_bf16(gg[1][0], gg[1][1]); v.w = cvt_pk_bf16(gg[1][2], gg[1][3]);
                    *(u32x4*)(rowp + (size_t)TOK * 1024) = v; }
            return;
        }
        const int sect = pn >> 1, head = (pn & 1) * 4 + wc, b = pm >> 4;
        if (sect == 2 || sect == 5) {
            bf16_t* vb = QKV + (size_t)sect * TOK * 512 + (size_t)(b * 8 + head) * 64 * SEQ;
            const int slot = ((fr >> 2) & 1) * 8 + ((fr >> 3) & 1) * 4 + (fr & 3);
            const int s0 = (pm & 15) * 256 + wr * 64 + slot;
#pragma unroll
            for (int ai = 0; ai < 2; ++ai)
#pragma unroll
                for (int m = 0; m < 4; ++m) { bf16_t* sp = vb + s0 + ai * HALF + m * 16;
#pragma unroll
                    for (int bj = 0; bj < 2; ++bj)
#pragma unroll
                        for (int n = 0; n < 2; ++n) { const f32x4 x = acc[ai][bj][m][n] * us; const unsigned w0 = cvt_pk_bf16(x[0], x[1]), w1 = cvt_pk_bf16(x[2], x[3]); const int d = 32 * bj + 8 * fq + 4 * n;
                            sp[(size_t)(d + 0) * SEQ] = (bf16_t)(w0 & 0xffffu); sp[(size_t)(d + 1) * SEQ] = (bf16_t)(w0 >> 16);
                            sp[(size_t)(d + 2) * SEQ] = (bf16_t)(w1 & 0xffffu); sp[(size_t)(d + 3) * SEQ] = (bf16_t)(w1 >> 16); } }
            return;
        }
        const bool isA = sect < 2, isK = (sect == 1 || sect == 4);
        const float* gain = gains + (sect < 2 ? sect : sect - 1) * 64;
        bf16_t* dst = QKV + (size_t)sect * TOK * 512;
        const float qs = isK ? 1.f : QSCALE;
        f32x4 gv[2][2], csum[2][2];
#pragma unroll
        for (int bj = 0; bj < 2; ++bj)
#pragma unroll
            for (int n = 0; n < 2; ++n) { gv[bj][n] = *(const f32x4*)(gain + 32 * bj + 8 * fq + 4 * n) * qs; csum[bj][n] = (f32x4){0.f, 0.f, 0.f, 0.f}; }
#pragma unroll
        for (int ai = 0; ai < 2; ++ai)
#pragma unroll
            for (int m = 0; m < 4; ++m) {
                const int row = rowt + ai * HALF + m * 16;
                float ss = 0.f;
#pragma unroll
                for (int bj = 0; bj < 2; ++bj)
#pragma unroll
                    for (int n = 0; n < 2; ++n) { const f32x4 x = acc[ai][bj][m][n]; ss += (x[0] * x[0] + x[1] * x[1]) + (x[2] * x[2] + x[3] * x[3]); }
                ss += __shfl_xor(ss, 16); ss += __shfl_xor(ss, 32);
                const float rn = __builtin_amdgcn_rsqf(ss * (us * us * (1.0f / 64.0f)) + NORM_EPS) * us;
                f32x4 v[2][2];
#pragma unroll
                for (int bj = 0; bj < 2; ++bj)
#pragma unroll
                    for (int n = 0; n < 2; ++n) v[bj][n] = acc[ai][bj][m][n] * rn * gv[bj][n];
                if (isA) {
                    const int pos = row & (SEQ - 1);
#pragma unroll
                    for (int n = 0; n < 2; ++n) {
                        f32x4 cs = (f32x4){1.f, 1.f, 1.f, 1.f}, sn = (f32x4){0.f, 0.f, 0.f, 0.f};
                        if (fq < 2) { cs = *(const f32x4*)(rope + pos * 16 + 4 * n); sn = *(const f32x4*)(rope + pos * 16 + 8 + 4 * n); }
                        if (fq == 0) sn = -sn;
#pragma unroll
                        for (int e = 0; e < 4; ++e) { const float o = __shfl_xor(v[0][n][e], 16); v[0][n][e] = v[0][n][e] * cs[e] + o * sn[e]; }
                    }
                }
#pragma unroll
                for (int bj = 0; bj < 2; ++bj) { u32x4 w; w.x = cvt_pk_bf16(v[bj][0][0], v[bj][0][1]); w.y = cvt_pk_bf16(v[bj][0][2], v[bj][0][3]); w.z = cvt_pk_bf16(v[bj][1][0], v[bj][1][1]); w.w = cvt_pk_bf16(v[bj][1][2], v[bj][1][3]);
                    *(u32x4*)(dst + (size_t)row * 512 + head * 64 + 32 * bj + 8 * fq) = w; }
                if (sect == 1) {
#pragma unroll
                    for (int bj = 0; bj < 2; ++bj)
#pragma unroll
                        for (int n = 0; n < 2; ++n) csum[bj][n] += v[bj][n];
                }
            }
        if (sect == 1) {
#pragma unroll
            for (int bj = 0; bj < 2; ++bj)
#pragma unroll
                for (int n = 0; n < 2; ++n) { f32x4 x = csum[bj][n];
#pragma unroll
                    for (int e = 0; e < 4; ++e) { float y = x[e]; y += __shfl_xor(y, 1); y += __shfl_xor(y, 2); y += __shfl_xor(y, 4); y += __shfl_xor(y, 8); x[e] = y; }
                    if (fr == 0) *(f32x4*)(KMP + ((size_t)((b * 8 + head) * 16 + (pm & 15)) * 2 + wr) * 64 + 32 * bj + 8 * fq + 4 * n) = x; }
        }
    }
};

struct EpiG2 {
    static constexpr bool PERM = true, AFTER_DRAIN = false, MID = true;
    const bf16_t* GATES; bf16_t* MERGED;
    __device__ __forceinline__ void mid(f32x4 (&acc)[2][2][4][2], const Unit& u, int wr, int wc, int fr, int fq) const {
        asm volatile("" : "+v"(fq)); int rowt = u.pm * BM + wr * 64 + fr; asm volatile("" : "+v"(rowt));
        const int colb = u.pn * BM + wc * 32 + 8 * fq; const int gtid = (wr * 4 + wc) * 64 + fq * 16 + fr;
        u32x4 a[2][4][2];
#pragma unroll
        for (int ai = 0; ai < 2; ++ai)
#pragma unroll
            for (int m = 0; m < 4; ++m)
#pragma unroll
                for (int bj = 0; bj < 2; ++bj) a[ai][m][bj] = *(const u32x4*)(GATES + ((((size_t)(u.pm * 8 + 2 * u.pn + bj) * 8 + (ai * 4 + m)) * 512 + gtid) * 8));
#pragma unroll
        for (int ai = 0; ai < 2; ++ai)
#pragma unroll
            for (int m = 0; m < 4; ++m)
#pragma unroll
                for (int bj = 0; bj < 2; ++bj) { const u32x4 c = a[ai][m][bj];
                    acc[ai][bj][m][0] *= (f32x4){bflo(c.x), bfhi(c.x), bflo(c.y), bfhi(c.y)}; acc[ai][bj][m][1] *= (f32x4){bflo(c.z), bfhi(c.z), bflo(c.w), bfhi(c.w)}; }
    }
    __device__ __forceinline__ void operator()(f32x4 (&acc)[2][2][4][2], const Unit& u, int wr, int wc, int fr, int fq) const {
        asm volatile("" : "+v"(fq)); int rowt = u.pm * BM + wr * 64 + fr; asm volatile("" : "+v"(rowt));
        const int colb = u.pn * BM + wc * 32 + 8 * fq; const int gtid = (wr * 4 + wc) * 64 + fq * 16 + fr;
#pragma unroll
        for (int ai = 0; ai < 2; ++ai)
#pragma unroll
            for (int m = 0; m < 4; ++m) { const size_t off = (size_t)(rowt + ai * HALF + m * 16) * 1024 + colb;
#pragma unroll
                for (int bj = 0; bj < 2; ++bj) { const u32x4 c = *(const u32x4*)(GATES + (size_t)TOK * 1024 + ((((size_t)(u.pm * 8 + 2 * u.pn + bj) * 8 + (ai * 4 + m)) * 512 + gtid) * 8));
                    const f32x4 v0 = acc[ai][bj][m][0] * (f32x4){bflo(c.x), bfhi(c.x), bflo(c.y), bfhi(c.y)}, v1 = acc[ai][bj][m][1] * (f32x4){bflo(c.z), bfhi(c.z), bflo(c.w), bfhi(c.w)};
                    u32x4 w; w.x = cvt_pk_bf16(v0[0], v0[1]); w.y = cvt_pk_bf16(v0[2], v0[3]); w.z = cvt_pk_bf16(v1[0], v1[1]); w.w = cvt_pk_bf16(v1[2], v1[3]);
                    *(u32x4*)(MERGED + off + bj * HALF) = w; }
                if (m == 3) asm volatile("" ::: "memory"); }
    }
};

struct EpiG3 {
    static constexpr bool PERM = true, AFTER_DRAIN = false, MID = false;
    const float* X; float* OUT; bf16_t* X1B; float* SSQ;
    __device__ __forceinline__ void mid(f32x4 (&acc)[2][2][4][2], const Unit& u, int wr, int wc, int fr, int fq) const {}
    __device__ __forceinline__ void operator()(f32x4 (&acc)[2][2][4][2], const Unit& u, int wr, int wc, int fr, int fq) const {
        asm volatile("" : "+v"(fq)); int rowt = u.pm * BM + wr * 64 + fr; asm volatile("" : "+v"(rowt));
        const int colb = u.pn * BM + wc * 32 + 8 * fq;
#pragma unroll
        for (int ai = 0; ai < 2; ++ai)
#pragma unroll
            for (int m = 0; m < 4; ++m) { const int row = rowt + ai * HALF + m * 16; const size_t off = (size_t)row * 1024 + colb; float ss = 0.f;
#pragma unroll
                for (int bj = 0; bj < 2; ++bj) { const f32x4 x0 = *(const f32x4*)(X + off + bj * HALF), x1 = *(const f32x4*)(X + off + bj * HALF + 4);
                    const f32x4 v0 = acc[ai][bj][m][0] + x0, v1 = acc[ai][bj][m][1] + x1;
                    u32x4 w; w.x = cvt_pk_bf16(v0[0], v0[1]); w.y = cvt_pk_bf16(v0[2], v0[3]); w.z = cvt_pk_bf16(v1[0], v1[1]); w.w = cvt_pk_bf16(v1[2], v1[3]);
                    *(u32x4*)(X1B + off + bj * HALF) = w;
                    ss += ((v0[0] * v0[0] + v0[1] * v0[1]) + (v0[2] * v0[2] + v0[3] * v0[3])) + ((v1[0] * v1[0] + v1[1] * v1[1]) + (v1[2] * v1[2] + v1[3] * v1[3])); }
                ss += __shfl_xor(ss, 16); ss += __shfl_xor(ss, 32);
                if (fq == 0) SSQ[(size_t)row * 16 + u.pn * 4 + wc] = ss;
                asm volatile("" ::: "memory"); }
    }
};

struct EpiG4 {
    static constexpr bool PERM = true, AFTER_DRAIN = false, MID = false;
    const float *SSQ, *cw, *cb; bf16_t* ACT; float *G01, *U01, *GT; PG8_LAS float* xch;
    __device__ __forceinline__ void mid(f32x4 (&acc)[2][2][4][2], const Unit& u, int wr, int wc, int fr, int fq) const {}
    __device__ __forceinline__ void operator()(f32x4 (&acc)[2][2][4][2], const Unit& u, int wr, int wc, int fr, int fq) const {
        int pm = u.pm, pn = u.pn; asm volatile("" : "+s"(pn), "+s"(pm)); asm volatile("" : "+v"(fq), "+v"(fr)); const int lane = fr + 16 * fq;
        int rowt = pm * BM + wr * 64 + fr; asm volatile("" : "+v"(rowt));
        const int fcol = pn * 128 + wc * 32 + 8 * fq, lcol = wc * 32 + 8 * fq;
#pragma unroll
        for (int ai = 0; ai < 2; ++ai)
#pragma unroll
            for (int m = 0; m < 4; ++m) { const f32x4 p = *(const f32x4*)(SSQ + (size_t)(rowt + ai * HALF + m * 16) * 16 + 4 * fq);
                float s = (p[0] + p[1]) + (p[2] + p[3]); s += __shfl_xor(s, 16); s += __shfl_xor(s, 32);
                const float r2 = __builtin_amdgcn_rsqf(s * (1.0f / 1024.0f) + NORM_EPS);
#pragma unroll
                for (int bj = 0; bj < 2; ++bj)
#pragma unroll
                    for (int n = 0; n < 2; ++n) acc[ai][bj][m][n] *= r2; }
        if (fr >= 14) {
#pragma unroll
            for (int ai = 0; ai < 2; ++ai)
#pragma unroll
                for (int n = 0; n < 2; ++n) *(PG8_LAS f32x4*)(xch + ((ai * 2 + wr) * 2 + (fr - 14)) * 128 + lcol + 4 * n) = acc[ai][1][3][n];
            if (wr == 1) {
#pragma unroll
                for (int n = 0; n < 2; ++n) *(f32x4*)(GT + ((size_t)pm * 2 + (fr - 14)) * DFF + fcol + 4 * n) = acc[1][1][3][n];
            }
        }
        if (fr < 2 && wr == 0) {
#pragma unroll
            for (int n = 0; n < 2; ++n) { *(f32x4*)(G01 + ((size_t)pm * 2 + fr) * DFF + fcol + 4 * n) = acc[0][1][0][n]; *(f32x4*)(U01 + ((size_t)pm * 2 + fr) * DFF + fcol + 4 * n) = acc[0][0][0][n]; }
        }
        PG8_EPI_BAR();
        f32x4 w0[2], w1[2], w2[2], bb[2];
#pragma unroll
        for (int n = 0; n < 2; ++n) { w0[n] = *(const f32x4*)(cw + fcol + 4 * n); w1[n] = *(const f32x4*)(cw + DFF + fcol + 4 * n); w2[n] = *(const f32x4*)(cw + 2 * DFF + fcol + 4 * n); bb[n] = *(const f32x4*)(cb + fcol + 4 * n); }
        const int src1 = (lane & 48) | ((fr + 15) & 15), src2 = (lane & 48) | ((fr + 14) & 15);
#pragma unroll
        for (int ai = 0; ai < 2; ++ai) {
            f32x4 l1[2], l2[2];
            {
                const bool has = (wr == 1) || (ai == 1);
                const int pidx = (wr == 1) ? (ai * 2 + 0) : (0 * 2 + 1);
#pragma unroll
                for (int n = 0; n < 2; ++n) {
                    f32x4 h0 = (f32x4){0.f, 0.f, 0.f, 0.f}, h1 = (f32x4){0.f, 0.f, 0.f, 0.f};
                    if (has) { h0 = *(const PG8_LAS f32x4*)(xch + (pidx * 2 + 0) * 128 + lcol + 4 * n); h1 = *(const PG8_LAS f32x4*)(xch + (pidx * 2 + 1) * 128 + lcol + 4 * n); }
                    l1[n] = h1; l2[n] = (fr == 0) ? h0 : h1;
                }
            }
#pragma unroll
            for (int m = 0; m < 4; ++m) {
                bf16_t* op = ACT + (size_t)(rowt + ai * HALF + m * 16) * DFF + fcol;
                u32x4 w;
#pragma unroll
                for (int n = 0; n < 2; ++n) {
                    const f32x4 cur = acc[ai][1][m][n], uu = acc[ai][0][m][n];
                    f32x4 p1, p2;
#pragma unroll
                    for (int e = 0; e < 4; ++e) { p1[e] = __shfl(cur[e], src1); p2[e] = __shfl(cur[e], src2); }
                    f32x4 a;
#pragma unroll
                    for (int e = 0; e < 4; ++e) { const float pv1 = (fr >= 1) ? p1[e] : l1[n][e], pv2 = (fr >= 2) ? p2[e] : l2[n][e];
                        const float cv = w0[n][e] * pv2 + w1[n][e] * pv1 + w2[n][e] * cur[e] + bb[n][e];
                        a[e] = cv * sigm(cv) * uu[e]; }
                    l1[n] = p1; l2[n] = p2;
                    if (n == 0) { w.x = cvt_pk_bf16(a[0], a[1]); w.y = cvt_pk_bf16(a[2], a[3]); } else { w.z = cvt_pk_bf16(a[0], a[1]); w.w = cvt_pk_bf16(a[2], a[3]); }
                }
                if (!(ai == 0 && m == 0 && wr == 0 && fr < 2 && (pm & 15) != 0)) *(u32x4*)op = w;
            }
        }
    }
};

struct EpiG5 {
    static constexpr bool PERM = true, AFTER_DRAIN = false, MID = false;
    float* OUT; const bf16_t* X1B;
    __device__ __forceinline__ void mid(f32x4 (&acc)[2][2][4][2], const Unit& u, int wr, int wc, int fr, int fq) const {}
    __device__ __forceinline__ void operator()(f32x4 (&acc)[2][2][4][2], const Unit& u, int wr, int wc, int fr, int fq) const {
        asm volatile("" : "+v"(fq)); int rowt = u.pm * BM + wr * 64 + fr; asm volatile("" : "+v"(rowt));
        const int colb = u.pn * BM + wc * 32 + 8 * fq;
#pragma unroll
        for (int ai = 0; ai < 2; ++ai)
#pragma unroll
            for (int m = 0; m < 4; ++m) { const size_t off = (size_t)(rowt + ai * HALF + m * 16) * 1024 + colb;
#pragma unroll
                for (int bj = 0; bj < 2; ++bj) { float* p = OUT + off + bj * HALF; const u32x4 xb = *(const u32x4*)(X1B + off + bj * HALF);
                    const f32x4 x0 = (f32x4){bflo(xb.x), bfhi(xb.x), bflo(xb.y), bfhi(xb.y)}, x1 = (f32x4){bflo(xb.z), bfhi(xb.z), bflo(xb.w), bfhi(xb.w)};
                    *(f32x4*)p = acc[ai][bj][m][0] + x0; *(f32x4*)(p + 4) = acc[ai][bj][m][1] + x1; }
                asm volatile("" ::: "memory"); }
    }
};
template <class Epi, class Sched, bool ALIGN_EPI = false, bool SP2 = false, bool F8 = false>
__device__ __forceinline__ void gemm_phase(PG8_LAS unsigned char* lds, const Gemm g, const Sched& S, const Epi& E) {
    int tid_ = threadIdx.x; asm volatile("" : "+v"(tid_));
    const int tid = tid_, wid = __builtin_amdgcn_readfirstlane(tid >> 6), lane = tid & 63, wr = wid >> 2, wc = wid & 3, fr = lane & 15, fq = lane >> 4;
    const int K = g.K, nt = F8 ? K / 128 : K / BK;
    unsigned voffA[2], voffB[2];
#pragma unroll
    for (int i = 0; i < 2; ++i) { int R, C; stage_rc(tid * 16 + i * 8192, R, C); const int Rb = Epi::PERM ? ((R & ~31) + perm32(R & 31)) : R;
        voffA[i] = F8 ? (unsigned)(R * K + 2 * C) : (unsigned)(R * K + C) * 2u; voffB[i] = F8 ? (unsigned)(Rb * K + 2 * C) : (unsigned)(Rb * K + C) * 2u; }
    const size_t kstep = (size_t)(BK * 2);
    const size_t hstep = (size_t)HALF * K * (F8 ? 1 : 2);
    const size_t tstep = 2 * hstep;
    const unsigned ldsw = (unsigned)wid * 1024u;
    const int aoff = lds_byte(wr * 64 + fr, F8 ? fq * 16 : fq * 8), boff = lds_byte(wc * 32 + fr, F8 ? fq * 16 : fq * 8);
#define PG8_SA(b, h) (((b) * 2 + (h)) * HTB)
#define PG8_SB(b, h) ((4 + (b) * 2 + (h)) * HTB)
#define PG8_STAGE(bufoff, gbase, voff) do { _Pragma("unroll") for (int _i = 0; _i < 2; ++_i) \
        __builtin_amdgcn_global_load_lds((const unsigned*)((const char*)(gbase) + (voff)[_i]), (PG8_LAS unsigned*)(lds + (bufoff) + ldsw + _i * 8192), 16, 0, 0); } while (0)
#define PG8_LDA(dst, b, h) do { _Pragma("unroll") for (int m = 0; m < 4; ++m) { if constexpr (F8) { dst##8[m] = *(const PG8_LAS v8ia_*)(lds + PG8_SA(b, h) + aoff + m * 2048); } else { _Pragma("unroll") for (int k = 0; k < 2; ++k) dst[m][k] = *(const PG8_LAS bf16x8*)(lds + PG8_SA(b, h) + aoff + m * 2048 + k * 1024); } } } while (0)
#define PG8_LDB(dst, b, h) do { _Pragma("unroll") for (int n = 0; n < 2; ++n) { if constexpr (F8) { dst##8[n] = *(const PG8_LAS v8ia_*)(lds + PG8_SB(b, h) + boff + n * 2048); } else { _Pragma("unroll") for (int k = 0; k < 2; ++k) dst[n][k] = *(const PG8_LAS bf16x8*)(lds + PG8_SB(b, h) + boff + n * 2048 + k * 1024); } } } while (0)
#define PG8_MMA(ai, bj, At, Bt) do { __builtin_amdgcn_s_setprio(1); _Pragma("unroll") for (int m = 0; m < 4; ++m) _Pragma("unroll") for (int n = 0; n < 2; ++n) { \
        if constexpr (F8) asm volatile("v_mfma_scale_f32_16x16x128_f8f6f4 %0, %1, %2, %0, %3, %3 op_sel_hi:[0,0,0]" : "+v"(acc[ai][bj][m][n]) : "v"(Bt##8[n]), "v"(At##8[m]), "v"(sc1_));   \
        else { _Pragma("unroll") for (int k = 0; k < 2; ++k) acc[ai][bj][m][n] = __builtin_amdgcn_mfma_f32_16x16x32_bf16(Bt[n][k], At[m][k], acc[ai][bj][m][n], 0, 0, 0); } } \
        __builtin_amdgcn_s_setprio(0); } while (0)
#define PG8_WAIT_V(n) asm volatile("s_waitcnt vmcnt(" #n ")" ::: "memory")
#define PG8_WAIT_L(n) asm volatile("s_waitcnt lgkmcnt(" #n ")" ::: "memory")
#define PG8_BAR asm volatile("s_barrier" ::: "memory")
#define PG8_SCHED __builtin_amdgcn_sched_barrier(0)
    Unit cur, nxt; int ui = 0;
    if (!S.next(0, cur)) return;
    f32x4 acc[2][2][4][2];
#pragma unroll
    for (int a = 0; a < 2; ++a)
#pragma unroll
        for (int b = 0; b < 2; ++b)
#pragma unroll
            for (int m = 0; m < 4; ++m)
#pragma unroll
                for (int n = 0; n < 2; ++n) { acc[a][b][m][n] = (f32x4){0.f, 0.f, 0.f, 0.f}; if constexpr (F8) asm volatile("" : "+v"(acc[a][b][m][n])); }
    typedef int v8i_ __attribute__((ext_vector_type(8))); typedef int v8ia_ __attribute__((ext_vector_type(8), aligned(16)));
    const int sc1_ = 0x7f7f7f7f;
    bf16x8 At[4][2], B0[2][2], B1[2][2]; v8i_ At8[4], B08[2], B18[2];
    const char* cA = (const char*)g.A + (size_t)cur.pm * tstep; const char* cB = (const char*)g.Bt + (size_t)cur.pn * tstep;
    S.a_ready(cur);
    if constexpr (SP2) {
        PG8_STAGE(PG8_SB(0, 0), cB, voffB); PG8_STAGE(PG8_SB(0, 1), cB + hstep, voffB); PG8_STAGE(PG8_SA(0, 0), cA, voffA); PG8_STAGE(PG8_SA(0, 1), cA + hstep, voffA);
        if (wr == 1) PG8_BAR;
        PG8_WAIT_V(2); PG8_BAR;
        PG8_STAGE(PG8_SB(1, 0), cB + kstep, voffB); PG8_STAGE(PG8_SA(1, 0), cA + kstep, voffA); PG8_STAGE(PG8_SB(1, 1), cB + hstep + kstep, voffB);
        PG8_WAIT_V(6); PG8_BAR;
    } else {
        PG8_STAGE(PG8_SB(0, 0), cB, voffB); PG8_STAGE(PG8_SA(0, 0), cA, voffA); PG8_STAGE(PG8_SB(0, 1), cB + hstep, voffB); PG8_STAGE(PG8_SA(0, 1), cA + hstep, voffA);
        if (wr == 1) PG8_BAR;
        PG8_WAIT_V(4); PG8_BAR;
        PG8_STAGE(PG8_SB(1, 0), cB + kstep, voffB); PG8_STAGE(PG8_SA(1, 0), cA + kstep, voffA); PG8_STAGE(PG8_SB(1, 1), cB + hstep + kstep, voffB);
        PG8_WAIT_V(6); PG8_BAR;
    }
    for (;;) {
        const bool has_next = S.next(ui + 1, nxt);
        const char* nA = has_next ? (const char*)g.A + (size_t)nxt.pm * tstep : cA; const char* nB = has_next ? (const char*)g.Bt + (size_t)nxt.pn * tstep : cB;
        for (int hh = 0; hh < (Epi::MID ? 2 : 1); ++hh) {
        if (Epi::MID && hh == 1) {
            if (ALIGN_EPI && wr == 0) PG8_BAR;
            E.mid(acc, cur, wr, wc, fr, fq); __builtin_amdgcn_sched_barrier(0);
            if (ALIGN_EPI && wr == 1) PG8_BAR; }
        const int t_lo = Epi::MID ? hh * (nt >> 1) : 0, t_hi = Epi::MID ? (hh + 1) * (nt >> 1) : nt;
        for (int t = t_lo; t < t_hi; t += 2) {
            const bool last = (t == nt - 2);
            const char* a1 = cA + (size_t)(t + 1) * kstep;
            const char* a2 = last ? nA : cA + (size_t)(t + 2) * kstep; const char* b2 = last ? nB : cB + (size_t)(t + 2) * kstep;
            const char* a3 = a2 + kstep; const char* b3 = b2 + kstep;
            if (last && has_next) S.a_ready(nxt);
            if constexpr (SP2) {
            PG8_LDB(B0, 0, 0); PG8_LDB(B1, 0, 1); PG8_SCHED; PG8_LDA(At, 0, 0); PG8_STAGE(PG8_SA(1, 1), a1 + hstep, voffA);
            PG8_WAIT_V(8); PG8_WAIT_L(0); PG8_BAR; PG8_MMA(0, 0, At, B0); PG8_MMA(0, 1, At, B1); PG8_BAR; PG8_SCHED;
            PG8_LDA(At, 0, 1); PG8_STAGE(PG8_SB(0, 0), b2, voffB); PG8_STAGE(PG8_SB(0, 1), b2 + hstep, voffB); PG8_STAGE(PG8_SA(0, 0), a2, voffA);
            PG8_WAIT_V(8); PG8_WAIT_L(0); PG8_BAR; PG8_MMA(1, 0, At, B0); PG8_MMA(1, 1, At, B1); PG8_BAR; PG8_SCHED;
            PG8_LDB(B0, 1, 0); PG8_LDB(B1, 1, 1); PG8_SCHED; PG8_LDA(At, 1, 0); PG8_STAGE(PG8_SA(0, 1), a2 + hstep, voffA);
            PG8_WAIT_V(8); PG8_WAIT_L(0); PG8_BAR; PG8_MMA(0, 0, At, B0); PG8_MMA(0, 1, At, B1); PG8_BAR; PG8_SCHED;
            PG8_LDA(At, 1, 1); PG8_STAGE(PG8_SB(1, 0), b3, voffB); PG8_STAGE(PG8_SB(1, 1), b3 + hstep, voffB); PG8_STAGE(PG8_SA(1, 0), a3, voffA);
            PG8_WAIT_V(8); PG8_WAIT_L(0); PG8_BAR; PG8_MMA(1, 0, At, B0); PG8_MMA(1, 1, At, B1); PG8_BAR; PG8_SCHED;
            } else {
            PG8_LDB(B0, 0, 0); PG8_SCHED; PG8_LDA(At, 0, 0); PG8_STAGE(PG8_SA(1, 1), a1 + hstep, voffA);
            PG8_WAIT_L(8); PG8_BAR; PG8_WAIT_L(0); PG8_MMA(0, 0, At, B0); PG8_BAR; PG8_SCHED;
            PG8_LDB(B1, 0, 1); PG8_STAGE(PG8_SB(0, 0), b2, voffB);
            PG8_BAR; PG8_WAIT_L(0); PG8_MMA(0, 1, At, B1); PG8_BAR;
            PG8_LDA(At, 0, 1); PG8_STAGE(PG8_SA(0, 0), a2, voffA);
            PG8_BAR; PG8_WAIT_L(0); PG8_MMA(1, 0, At, B0); PG8_BAR; PG8_SCHED;
            PG8_STAGE(PG8_SB(0, 1), b2 + hstep, voffB);
            PG8_WAIT_V(6); PG8_BAR; PG8_MMA(1, 1, At, B1); PG8_BAR;
            PG8_LDB(B0, 1, 0); PG8_SCHED; PG8_LDA(At, 1, 0); PG8_STAGE(PG8_SA(0, 1), a2 + hstep, voffA);
            PG8_WAIT_L(8); PG8_BAR; PG8_WAIT_L(0); PG8_MMA(0, 0, At, B0); PG8_BAR; PG8_SCHED;
            PG8_LDB(B1, 1, 1); PG8_STAGE(PG8_SB(1, 0), b3, voffB);
            PG8_BAR; PG8_WAIT_L(0); PG8_MMA(0, 1, At, B1); PG8_BAR;
            PG8_LDA(At, 1, 1); PG8_STAGE(PG8_SA(1, 0), a3, voffA);
            PG8_BAR; PG8_WAIT_L(0); PG8_MMA(1, 0, At, B0); PG8_BAR; PG8_SCHED;
            PG8_STAGE(PG8_SB(1, 1), b3 + hstep, voffB);
            PG8_WAIT_V(6); PG8_BAR; PG8_MMA(1, 1, At, B1); PG8_BAR;
            }
        }
        }
        if constexpr (ALIGN_EPI) { if (wr == 0) PG8_BAR; }
        if constexpr (F8) asm volatile("s_nop 15\n\ts_nop 15" ::: "memory");
        if constexpr (!Epi::AFTER_DRAIN) { E(acc, cur, wr, wc, fr, fq); S.done(cur); }
        if (!has_next) break;
#pragma unroll
        for (int a = 0; a < 2; ++a)
#pragma unroll
            for (int b = 0; b < 2; ++b)
#pragma unroll
                for (int m = 0; m < 4; ++m)
#pragma unroll
                    for (int n = 0; n < 2; ++n) { acc[a][b][m][n] = (f32x4){0.f, 0.f, 0.f, 0.f}; if constexpr (F8) asm volatile("" : "+v"(acc[a][b][m][n])); }
        cur = nxt; cA = nA; cB = nB; ++ui;
        if constexpr (ALIGN_EPI) { if (wr == 1) PG8_BAR; }
    }
    PG8_WAIT_V(0);
    if constexpr (!ALIGN_EPI) { if (wr == 0) PG8_BAR; }
    PG8_BAR;
    if constexpr (Epi::AFTER_DRAIN) { E.fused(acc, cur, wr, wc, fr, fq, lds, wid, lane); S.done(cur); }
#undef PG8_SA
#undef PG8_SB
#undef PG8_STAGE
#undef PG8_LDA
#undef PG8_LDB
#undef PG8_MMA
#undef PG8_WAIT_V
#undef PG8_WAIT_L
#undef PG8_BAR
#undef PG8_SCHED
}

}
namespace att {
#define ALAS __attribute__((address_space(3)))
typedef short bf16x8 __attribute__((ext_vector_type(8)));
typedef float f32x16 __attribute__((ext_vector_type(16)));
typedef float f32x4 __attribute__((ext_vector_type(4)));
typedef unsigned u32x4 __attribute__((ext_vector_type(4)));
typedef unsigned u32x2 __attribute__((ext_vector_type(2)));
typedef unsigned short bf16_t;
typedef int v8i_ __attribute__((ext_vector_type(8))); typedef int v8ia_ __attribute__((ext_vector_type(8), aligned(16)));
constexpr int ROW8 = 80;
constexpr int ROWB = 144, TILEB = 64 * ROWB;
constexpr int L_K = 0, L_V = 4 * TILEB, L_C = 8 * TILEB, L_KM = L_C + 1024, L_SEL = L_KM + 4096, L_END = L_SEL + 1024;
constexpr float NEG = -1e30f;
constexpr float THR = 58.0f;
struct Tens { const bf16_t *QA, *KA, *VTA, *QB, *KB, *VTB; bf16_t* O; const float *KMP, *CL; };
__device__ __forceinline__ unsigned pk(float lo, float hi) { return pg8::cvt_pk_bf16(lo, hi); }
__device__ __forceinline__ float blo(unsigned w) { return __uint_as_float(w << 16); }
__device__ __forceinline__ float bhi(unsigned w) { return __uint_as_float(w & 0xffff0000u); }
#define AMFMA(a, b, c) __builtin_amdgcn_mfma_f32_32x32x16_bf16(a, b, c, 0, 0, 0)

template <bool FOX> __device__ __forceinline__ void unit(ALAS unsigned char* lds, const Tens& T, int bh, int qb, float qk2max, float qk2max_a) {
    int tid_ = threadIdx.x; asm volatile("" : "+v"(tid_));
    const int tid = tid_, lane = tid & 63, r32 = lane & 31, hi = lane >> 5;
    const int w = __builtin_amdgcn_readfirstlane(tid >> 6);
    const int b = bh >> 3, h = bh & 7;
    const size_t rowbase = (size_t)b * SEQ; const int q0 = qb * 256;
    const bf16_t* Q = FOX ? T.QB : T.QA; const bf16_t* K = FOX ? T.KB : T.KA; const bf16_t* VT = (FOX ? T.VTB : T.VTA) + (size_t)bh * 64 * SEQ;
    const float* CLs = T.CL + (size_t)bh * SEQ;
    bf16x8 qr[4];
    { const bf16_t* qp = Q + (rowbase + q0 + 32 * w + r32) * 512 + h * 64 + 8 * hi;
#pragma unroll
      for (int d0 = 0; d0 < 4; ++d0) qr[d0] = *(const bf16x8*)(qp + 16 * d0); }
    unsigned selq = 0u; float cq = 0.f, cqw = 0.f, cq0 = 0.f;
    v8i_ q8 = {};
    if constexpr (!FOX) { const u32x4* qp8 = (const u32x4*)(Q + (rowbase + q0 + 32 * w + r32) * 512 + h * 64 + 32 * hi);
#pragma unroll
        for (int j = 0; j < 4; ++j) { const u32x4 v = qp8[j];
            int a = __builtin_amdgcn_cvt_pk_fp8_f32(blo(v.x), bhi(v.x), 0, false); a = __builtin_amdgcn_cvt_pk_fp8_f32(blo(v.y), bhi(v.y), a, true);
            int c = __builtin_amdgcn_cvt_pk_fp8_f32(blo(v.z), bhi(v.z), 0, false); c = __builtin_amdgcn_cvt_pk_fp8_f32(blo(v.w), bhi(v.w), c, true);
            q8[2 * j] = a; q8[2 * j + 1] = c; } }
    if constexpr (!FOX) {
        ALAS float* KM = (ALAS float*)(lds + L_KM); ALAS unsigned* SEL = (ALAS unsigned*)(lds + L_SEL);
        { const int qi = tid >> 1, half = tid & 1;
          const u32x4* qp = (const u32x4*)(Q + (rowbase + q0 + qi) * 512 + h * 64 + 32 * half);
          float qf[32];
#pragma unroll
          for (int j = 0; j < 4; ++j) { const u32x4 v = qp[j]; qf[8 * j + 0] = blo(v.x); qf[8 * j + 1] = bhi(v.x); qf[8 * j + 2] = blo(v.y); qf[8 * j + 3] = bhi(v.y); qf[8 * j + 4] = blo(v.z); qf[8 * j + 5] = bhi(v.z); qf[8 * j + 6] = blo(v.w); qf[8 * j + 7] = bhi(v.w); }
          float v1 = -INFINITY, v2 = -INFINITY, v3 = -INFINITY; int i1 = 0, i2 = 0, i3 = 0;
          for (int n = 0; n < qb; ++n) {
              const ALAS f32x4* kp = (const ALAS f32x4*)(KM + n * 64 + 32 * half); float g = 0.f;
#pragma unroll
              for (int j = 0; j < 8; ++j) { const f32x4 kk = kp[j]; g += (qf[4 * j] * kk[0] + qf[4 * j + 1] * kk[1]) + (qf[4 * j + 2] * kk[2] + qf[4 * j + 3] * kk[3]); }
              g += __shfl_xor(g, 1);
              if (g > v1) { v3 = v2; i3 = i2; v2 = v1; i2 = i1; v1 = g; i1 = n; } else if (g > v2) { v3 = v2; i3 = i2; v2 = g; i2 = n; } else if (g > v3) { v3 = g; i3 = n; }
          }
          const unsigned mask = (qb <= 3) ? ((1u << qb) - 1u) : ((1u << i1) | (1u << i2) | (1u << i3));
          if (half == 0) SEL[qi] = mask; }
        __syncthreads();
        selq = SEL[32 * w + r32];
    } else { cq = CLs[q0 + 32 * w + r32]; cqw = CLs[q0 + 32 * w]; cq0 = CLs[q0]; }
    const int NTmax = 4 + 4 * qb;
#define KV0(i) (FOX ? (q0 + 192 - 64 * (i)) : ((i) < 4 ? q0 + 64 * (i) : 64 * ((i) - 4)))
    const bf16_t* kg = K + (rowbase + (tid >> 3)) * 512 + h * 64 + (tid & 7) * 8;
    const bf16_t* vg = VT + (size_t)(tid >> 3) * SEQ + (tid & 7) * 8;
    const unsigned stoff = FOX ? (unsigned)((tid >> 3) * ROWB + (tid & 7) * 16) : (unsigned)((tid >> 3) * ROW8 + (tid & 7) * 8);
    const unsigned stoffv = (unsigned)((tid >> 3) * ROWB + (tid & 7) * 16);
    u32x4 kA0, vA0, kA1, vA1; f32x4 cA0 = (f32x4){0.f, 0.f, 0.f, 0.f}, cA1 = cA0;
#define LOADT(KR, VR, CR, kv) do { KR = *(const u32x4*)(kg + (size_t)(kv) * 512); VR = *(const u32x4*)(vg + (kv)); if (FOX && tid < 16) CR = *(const f32x4*)(CLs + (kv) + 4 * tid); } while (0)
#define CVT8(R) (u32x2){(unsigned)__builtin_amdgcn_cvt_pk_fp8_f32(blo(R.y), bhi(R.y), __builtin_amdgcn_cvt_pk_fp8_f32(blo(R.x), bhi(R.x), 0, false), true), (unsigned)__builtin_amdgcn_cvt_pk_fp8_f32(blo(R.w), bhi(R.w), __builtin_amdgcn_cvt_pk_fp8_f32(blo(R.z), bhi(R.z), 0, false), true)}
#define STORET(KR, VR, CR, sl) do { if (FOX) { *(ALAS u32x4*)(lds + L_K + (sl) * TILEB + stoff) = KR; *(ALAS u32x4*)(lds + L_V + (sl) * TILEB + stoff) = VR; if (tid < 16) *(ALAS f32x4*)(lds + L_C + (sl) * 256 + 16 * tid) = CR; } \
        else { *(ALAS u32x2*)(lds + L_K + (sl) * TILEB + stoff) = CVT8(KR); *(ALAS u32x4*)(lds + L_V + (sl) * TILEB + stoffv) = VR; } } while (0)
    int NT = NTmax;
    if (FOX) {
        const int kk = q0 - 1 - 64 * lane; const float cv = CLs[kk < 0 ? 0 : kk];
        const unsigned long long ok = __builtin_amdgcn_ballot_w64((kk >= 0) && ((2.f * qk2max + cq0 - cv) >= -THR));
        const int npast = (~ok == 0ull) ? 64 : __builtin_ctzll(~ok);
        NT = 4 + (npast < 4 * qb ? npast : 4 * qb);
    }
    const int NS = (NT + 1) >> 1;
    const float qkref = FOX ? qk2max : qk2max_a; const float cqb = cq - qkref;
    float l = 0.f; f32x16 o0 = {}, o1 = {}; const int sc1a = 0x7f7f7f7f;
#define SKIPT(i, sl, OUT) do { const bool diag_ = (i) < 4; const int j_ = FOX ? 3 - (i) : (i); OUT = diag_ && (j_ > (w >> 1)); \
        if (FOX) { const float ckl = *(const ALAS float*)(lds + L_C + (sl) * 256 + 252); if ((2.f * qk2max + cqw - ckl) < -THR) OUT = true; } } while (0)
#define S_PART(P0, P1, i, sl, kv0) do { \
        if (FOX) { const ALAS unsigned char* cbp = lds + L_C + (sl) * 256 + hi * 16; \
            _Pragma("unroll") for (int g = 0; g < 4; ++g) { const f32x4 c0 = *(const ALAS f32x4*)(cbp + g * 32), c1 = *(const ALAS f32x4*)(cbp + 128 + g * 32); \
                _Pragma("unroll") for (int e = 0; e < 4; ++e) { P0[4 * g + e] = cqb - c0[e]; P1[4 * g + e] = cqb - c1[e]; } } } \
        else { const float cb = (((i) < 4) || ((selq >> ((kv0) >> 8)) & 1u)) ? -qkref : NEG; \
            _Pragma("unroll") for (int r = 0; r < 16; ++r) { P0[r] = cb; P1[r] = cb; } } \
        if (FOX) { const ALAS unsigned char* kb = lds + L_K + (sl) * TILEB + r32 * ROWB + hi * 16; \
            _Pragma("unroll") for (int d0 = 0; d0 < 4; ++d0) { const bf16x8 a0 = *(const ALAS bf16x8*)(kb + d0 * 32), a1 = *(const ALAS bf16x8*)(kb + 32 * ROWB + d0 * 32); P0 = AMFMA(a0, qr[d0], P0); P1 = AMFMA(a1, qr[d0], P1); } } \
        else { const ALAS unsigned char* kb = lds + L_K + (sl) * TILEB + r32 * ROW8 + hi * 32; \
            const v8i_ a0 = *(const ALAS v8ia_*)kb, a1 = *(const ALAS v8ia_*)(kb + 32 * ROW8); \
            P0 = __builtin_amdgcn_mfma_scale_f32_32x32x64_f8f6f4(a0, q8, P0, 0, 0, 0, 0x7f7f7f7f, 0, 0x7f7f7f7f); P1 = __builtin_amdgcn_mfma_scale_f32_32x32x64_f8f6f4(a1, q8, P1, 0, 0, 0, 0x7f7f7f7f, 0, 0x7f7f7f7f); } } while (0)
#define M_PART(P0, P1, i) do { if ((i) < 4) { const int j_ = FOX ? 3 - (i) : (i); const int qrel = 32 * w + r32, kb0 = 64 * j_ + 4 * hi; \
            _Pragma("unroll") for (int r = 0; r < 16; ++r) { const int kvr = kb0 + (r & 3) + 8 * (r >> 2); if (kvr > qrel) P0[r] = NEG; if (kvr + 32 > qrel) P1[r] = NEG; } } } while (0)
#define E_PART(P0, P1) do { float sum = 0.f; \
        _Pragma("unroll") for (int r = 0; r < 16; ++r) { P0[r] = __builtin_amdgcn_exp2f(P0[r]); P1[r] = __builtin_amdgcn_exp2f(P1[r]); sum += P0[r] + P1[r]; } \
        l += sum; } while (0)
#define PV_PART(P0, P1, sl) do { if (true) { const ALAS unsigned char* vbp = lds + L_V + (sl) * TILEB + r32 * ROWB + hi * 16; \
        _Pragma("unroll") for (int s_ = 0; s_ < 4; ++s_) { const int rb = 8 * (s_ & 1); u32x4 pw; \
            if (s_ < 2) { pw.x = pk(P0[rb], P0[rb + 1]); pw.y = pk(P0[rb + 2], P0[rb + 3]); pw.z = pk(P0[rb + 4], P0[rb + 5]); pw.w = pk(P0[rb + 6], P0[rb + 7]); } \
            else        { pw.x = pk(P1[rb], P1[rb + 1]); pw.y = pk(P1[rb + 2], P1[rb + 3]); pw.z = pk(P1[rb + 4], P1[rb + 5]); pw.w = pk(P1[rb + 6], P1[rb + 7]); } \
            const bf16x8 pb = __builtin_bit_cast(bf16x8, pw); \
            const bf16x8 a0 = *(const ALAS bf16x8*)(vbp + s_ * 32), a1 = *(const ALAS bf16x8*)(vbp + 32 * ROWB + s_ * 32); \
            o0 = AMFMA(a0, pb, o0); o1 = AMFMA(a1, pb, o1); } } \
        else { v8i_ pw8; \
            _Pragma("unroll") for (int j_ = 0; j_ < 4; ++j_) { int a_ = __builtin_amdgcn_cvt_pk_fp8_f32(P0[4 * j_], P0[4 * j_ + 1], 0, false); a_ = __builtin_amdgcn_cvt_pk_fp8_f32(P0[4 * j_ + 2], P0[4 * j_ + 3], a_, true); pw8[j_] = a_; \
                int c_ = __builtin_amdgcn_cvt_pk_fp8_f32(P1[4 * j_], P1[4 * j_ + 1], 0, false); c_ = __builtin_amdgcn_cvt_pk_fp8_f32(P1[4 * j_ + 2], P1[4 * j_ + 3], c_, true); pw8[4 + j_] = c_; } \
            const ALAS unsigned char* vb8 = lds + L_V + (sl) * TILEB + r32 * ROW8 + hi * 32; \
            const v8i_ a0 = *(const ALAS v8ia_*)vb8, a1 = *(const ALAS v8ia_*)(vb8 + 32 * ROW8); \
            o0 = __builtin_amdgcn_mfma_scale_f32_32x32x64_f8f6f4(a0, pw8, o0, 0, 0, 0, 0x7f7f7f7f, 0, 0x7f7f7f7f); o1 = __builtin_amdgcn_mfma_scale_f32_32x32x64_f8f6f4(a1, pw8, o1, 0, 0, 0, 0x7f7f7f7f, 0, 0x7f7f7f7f); } } while (0)
#define COMPUTE2(i, sl) do { bool ska, skb; SKIPT((i), (sl), ska); SKIPT((i) + 1, (sl) + 1, skb); \
        if (!ska && !skb) { f32x16 pa0, pa1, pb0, pb1; \
            S_PART(pa0, pa1, (i), (sl), KV0(i)); S_PART(pb0, pb1, (i) + 1, (sl) + 1, KV0((i) + 1)); \
            M_PART(pa0, pa1, (i)); M_PART(pb0, pb1, (i) + 1); E_PART(pa0, pa1); E_PART(pb0, pb1); \
            PV_PART(pa0, pa1, (sl)); PV_PART(pb0, pb1, (sl) + 1); } \
        else { if (!ska) { f32x16 pa0, pa1; S_PART(pa0, pa1, (i), (sl), KV0(i)); M_PART(pa0, pa1, (i)); E_PART(pa0, pa1); PV_PART(pa0, pa1, (sl)); } \
               if (!skb) { f32x16 pb0, pb1; S_PART(pb0, pb1, (i) + 1, (sl) + 1, KV0((i) + 1)); M_PART(pb0, pb1, (i) + 1); E_PART(pb0, pb1); PV_PART(pb0, pb1, (sl) + 1); } } } while (0)
    {
        LOADT(kA0, vA0, cA0, KV0(0)); LOADT(kA1, vA1, cA1, KV0(1));
        for (int S = 0;; ++S) {
            const int sl = (S & 1) * 2;
            STORET(kA0, vA0, cA0, sl); STORET(kA1, vA1, cA1, sl + 1); __syncthreads();
            const bool more = (S + 1) < NS; if (more) { LOADT(kA0, vA0, cA0, KV0(2 * S + 2)); LOADT(kA1, vA1, cA1, KV0(2 * S + 3)); }
            COMPUTE2(2 * S, sl);
            if (!more) break;
        }
    }
    __syncthreads();
#undef COMPUTE2
#undef SKIPT
#undef S_PART
#undef M_PART
#undef E_PART
#undef PV_PART
    l += __shfl_xor(l, 32);
    const float inv = 1.0f / l;
    bf16_t* op = T.O + (rowbase + q0 + 32 * w + r32) * 1024 + (FOX ? 512 : 0) + h * 64 + 4 * hi;
#pragma unroll
    for (int g = 0; g < 4; ++g) { u32x2 v; v.x = pk(o0[4 * g] * inv, o0[4 * g + 1] * inv); v.y = pk(o0[4 * g + 2] * inv, o0[4 * g + 3] * inv); *(u32x2*)(op + 8 * g) = v;
        u32x2 z; z.x = pk(o1[4 * g] * inv, o1[4 * g + 1] * inv); z.y = pk(o1[4 * g + 2] * inv, o1[4 * g + 3] * inv); *(u32x2*)(op + 32 + 8 * g) = z; }
#undef KV0
#undef LOADT
#undef STORET
}
}

#define LAS __attribute__((address_space(3)))
typedef unsigned short bf16;
typedef unsigned v4u __attribute__((ext_vector_type(4)));
typedef unsigned v2u __attribute__((ext_vector_type(2)));
typedef float f32x4 __attribute__((ext_vector_type(4)));
constexpr size_t MiB = 1u << 20;
constexpr size_t WS_WIN = 1 * MiB, WS_WBR = 11 * MiB, WS_WOUT = 13 * MiB, WS_WUP = 15 * MiB, WS_WDN = 26 * MiB, WS_ROPE = 32 * MiB, WS_LOGF = 33 * MiB, WS_CL = 35 * MiB,
                 WS_KMP = 37 * MiB, WS_SSQ = 38 * MiB, WS_G01 = 42 * MiB, WS_U01 = 48 * MiB, WS_GT = 54 * MiB, WS_H = 64 * MiB, WS_QKV = 192 * MiB, WS_GATES = 576 * MiB, WS_O = 832 * MiB, WS_END = 960 * MiB;
constexpr size_t WS_MERGED = WS_H, WS_ACT = WS_QKV, WS_X1B = WS_GATES;
constexpr int RING_BYTES = 131072, XCH_OFF = RING_BYTES, LDS_BYTES = 147456;
constexpr int NWAVES = 8;
#define XSYNC() xcd_barrier(xbar)
#define GEMM_PHASE(EPI) pg8::gemm_phase<EPI, pg8::StaticOrder, true, true>(lds, g, S, E)
#define GSYNC() do { asm volatile("s_waitcnt vmcnt(0) lgkmcnt(0)" ::: "memory"); __syncthreads(); \
    if (threadIdx.x == 0) { __builtin_amdgcn_fence(__ATOMIC_RELEASE, "agent"); asm volatile("s_waitcnt vmcnt(0)" ::: "memory"); } __syncthreads(); \
    grid.sync(); \
    if (threadIdx.x == 0) { __builtin_amdgcn_fence(__ATOMIC_ACQUIRE, "agent"); asm volatile("s_waitcnt vmcnt(0)" ::: "memory"); } __syncthreads(); } while (0)

struct Params { const float* in[17]; float* out; unsigned char* ws; };

__device__ __forceinline__ float wave_sum(float v) {
#pragma unroll
    for (int o = 1; o < 64; o <<= 1) v += __shfl_xor(v, o);
    return v;
}
__device__ __forceinline__ unsigned f2bf(float f) { unsigned u = __builtin_bit_cast(unsigned, f); return (u + 0x7fffu + ((u >> 16) & 1u)) >> 16; }
__device__ __forceinline__ unsigned pk2(float lo, float hi) { return f2bf(lo) | (f2bf(hi) << 16); }

__device__ __forceinline__ void tr_item(const float* W, int ldn, int k0, int nsrc0, bf16* WT, int ldk, int ndst0, int kd0, const float* ksc, LAS float* scr, int lane) {
#pragma unroll 8
    for (int i = 0; i < 32; ++i) { const int kk = 2 * i + (lane >> 5); float v = W[(size_t)(k0 + kk) * ldn + nsrc0 + (lane & 31)]; if (ksc) v *= ksc[k0 + kk]; scr[kk * 33 + (lane & 31)] = v; }
    asm volatile("s_waitcnt lgkmcnt(0)" ::: "memory");
    const int c = lane & 7;
#pragma unroll
    for (int j = 0; j < 4; ++j) { const int n = (lane >> 3) + 8 * j; const LAS float* s = scr + (8 * c) * 33 + n;
        v4u o; o.x = pk2(s[0 * 33], s[1 * 33]); o.y = pk2(s[2 * 33], s[3 * 33]); o.z = pk2(s[4 * 33], s[5 * 33]); o.w = pk2(s[6 * 33], s[7 * 33]);
        *(v4u*)(WT + (size_t)(ndst0 + n) * ldk + kd0 + k0 + 8 * c) = o; }
    asm volatile("s_waitcnt lgkmcnt(0)" ::: "memory");
}
__device__ __forceinline__ void tr_item8(const float* W, int ldn, int k0, int nsrc0, unsigned char* WT8, int ldk, int ndst0, float scale, LAS float* scr, int lane) {
#pragma unroll 8
    for (int i = 0; i < 32; ++i) { const int kk = 2 * i + (lane >> 5); scr[kk * 33 + (lane & 31)] = W[(size_t)(k0 + kk) * ldn + nsrc0 + (lane & 31)] * scale; }
    asm volatile("s_waitcnt lgkmcnt(0)" ::: "memory");
    const int c = lane & 7;
#pragma unroll
    for (int j = 0; j < 4; ++j) { const int n = (lane >> 3) + 8 * j; const LAS float* sp = scr + (8 * c) * 33 + n;
        int w0 = __builtin_amdgcn_cvt_pk_fp8_f32(sp[0 * 33], sp[1 * 33], 0, false); w0 = __builtin_amdgcn_cvt_pk_fp8_f32(sp[2 * 33], sp[3 * 33], w0, true);
        int w1 = __builtin_amdgcn_cvt_pk_fp8_f32(sp[4 * 33], sp[5 * 33], 0, false); w1 = __builtin_amdgcn_cvt_pk_fp8_f32(sp[6 * 33], sp[7 * 33], w1, true);
        v2u o; o.x = (unsigned)w0; o.y = (unsigned)w1;
        *(v2u*)(WT8 + (size_t)(ndst0 + n) * ldk + k0 + 8 * c) = o; }
    asm volatile("s_waitcnt lgkmcnt(0)" ::: "memory");
}


#define XB_TMO      128
#define XB_XCNT(j)  (256  + 64 * (j))
#define XB_XSUB(j)  (1280 + 64 * (j))
#define XB_XGEN(j)  (2304 + 64 * (j))
#define XB_TOP      3328
#define XB_TOPGEN   3392
#define XCD_BAR_WORDS 3456
#define XB_SPIN_CAP (1u << 18)

__device__ __forceinline__ unsigned xb_ld(unsigned* p)              { return __hip_atomic_load(p, __ATOMIC_RELAXED, __HIP_MEMORY_SCOPE_AGENT); }
__device__ __forceinline__ unsigned xb_add(unsigned* p, unsigned v) { return __hip_atomic_fetch_add(p, v, __ATOMIC_RELAXED, __HIP_MEMORY_SCOPE_AGENT); }
__device__ __forceinline__ unsigned xb_xcc_id() { return (unsigned)__builtin_amdgcn_s_getreg((3 << 11) | 20) & 0xFu; }
#define XB_SPIN(cond, bar) do { unsigned _sp = 0; while (cond) { __builtin_amdgcn_s_sleep(1); \
    if ((++_sp & 255u) == 0u) { if (xb_ld(&(bar)[XB_TMO])) break; if (_sp > XB_SPIN_CAP) { atomicAdd(&(bar)[XB_TMO], 1u); break; } } } } while (0)

struct XcdBarrier {
    unsigned* bar; unsigned x;
    volatile LAS unsigned* st;
};

__device__ __forceinline__ XcdBarrier xcd_barrier_post(unsigned* bar, volatile LAS unsigned* st) {
    XcdBarrier b; b.bar = bar; b.x = xb_xcc_id(); b.st = st;
    if (threadIdx.x == 0) (void)xb_add(&bar[XB_XCNT(b.x)], 1u);
    return b;
}
__device__ __forceinline__ void xcd_barrier_complete(unsigned* bar, unsigned x, unsigned& nloc, unsigned& nx) {
    const unsigned G = gridDim.x * gridDim.y * gridDim.z;
    unsigned sum, cnt, mine, sp = 0u;
    for (;;) {
        sum = 0u; cnt = 0u; mine = 0u;
#pragma unroll
        for (unsigned j = 0; j < 16; ++j) { const unsigned c = xb_ld(&bar[XB_XCNT(j)]); sum += c; cnt += (c > 0u) ? 1u : 0u; mine = (j == x) ? c : mine; }
        if (sum == G) break;
        __builtin_amdgcn_s_sleep(1);
        if ((++sp & 255u) == 0u) { if (xb_ld(&bar[XB_TMO])) break; if (sp > XB_SPIN_CAP) { atomicAdd(&bar[XB_TMO], 1u); break; } }
    }
    nloc = mine > 0u ? mine : 1u; nx = cnt > 0u ? cnt : 1u;
}

__device__ __forceinline__ void xcd_barrier(const XcdBarrier& b) {
    asm volatile("s_waitcnt vmcnt(0)" ::: "memory");
    __syncthreads();
    if (threadIdx.x == 0) {
        unsigned* bar = b.bar;
        __builtin_amdgcn_s_waitcnt(0);
        unsigned nloc = b.st[0], nx = b.st[1];
        if (nloc == 0u) { xcd_barrier_complete(bar, b.x, nloc, nx); b.st[0] = nloc; b.st[1] = nx; }
        const unsigned old = xb_add(&bar[XB_XSUB(b.x)], 1u);
        const unsigned gen = old / nloc;
        if (old + 1u == (gen + 1u) * nloc) {
            __builtin_amdgcn_fence(__ATOMIC_RELEASE, "agent");
            asm volatile("s_waitcnt vmcnt(0)" ::: "memory");
            const unsigned og = xb_add(&bar[XB_TOP], 1u);
            const unsigned tg = og / nx;
            if (og + 1u == (tg + 1u) * nx) xb_add(&bar[XB_TOPGEN], 1u);
            else XB_SPIN(xb_ld(&bar[XB_TOPGEN]) == tg, bar);
            __builtin_amdgcn_fence(__ATOMIC_ACQUIRE, "agent");
            xb_add(&bar[XB_XGEN(b.x)], 1u);
            asm volatile("s_waitcnt vmcnt(0)" ::: "memory");
        } else {
            XB_SPIN(xb_ld(&bar[XB_XGEN(b.x)]) == gen, bar);
            __builtin_amdgcn_fence(__ATOMIC_ACQUIRE, "agent");
            asm volatile("s_waitcnt vmcnt(0)" ::: "memory");
        }
    }
    __syncthreads();
}

#define WT_IN ((bf16*)(P.ws + WS_WIN))
#define WT_BR ((bf16*)(P.ws + WS_WBR))
#define WT_OUT ((bf16*)(P.ws + WS_WOUT))
#define WT_UP ((bf16*)(P.ws + WS_WUP))
#define WT_DN ((bf16*)(P.ws + WS_WDN))
#define ROPE ((float*)(P.ws + WS_ROPE))
#define GAINS ((float*)(P.ws + WS_ROPE + 512 * 1024))
#define LOGF ((float*)(P.ws + WS_LOGF))
#define CL ((float*)(P.ws + WS_CL))
#define KMP ((float*)(P.ws + WS_KMP))
#define SSQ ((float*)(P.ws + WS_SSQ))
#define G01 ((float*)(P.ws + WS_G01))
#define U01 ((float*)(P.ws + WS_U01))
#define GT ((float*)(P.ws + WS_GT))
#define H ((bf16*)(P.ws + WS_H))
#define H8 ((unsigned char*)(P.ws + WS_O))
#define WT_IN8 ((unsigned char*)(P.ws + WS_WIN + 6 * MiB))
#define MERGED ((bf16*)(P.ws + WS_MERGED))
#define ACT ((bf16*)(P.ws + WS_ACT))
#define X1B ((bf16*)(P.ws + WS_X1B))
#define GATES ((bf16*)(P.ws + WS_GATES))
#define OB ((bf16*)(P.ws + WS_O))
#define QA ((bf16*)(P.ws + WS_QKV))
#define KA (QA + (size_t)TOK * 512)
#define VTA (QA + (size_t)TOK * 1024)
#define QB (QA + (size_t)TOK * 1536)
#define KB (QA + (size_t)TOK * 2048)
#define VTB (QA + (size_t)TOK * 2560)
__global__ void __launch_bounds__(512, 2) fwd(Params P) {
    extern __shared__ __attribute__((aligned(16))) unsigned char lds_raw[];
    cg::grid_group grid = cg::this_grid();
    LAS unsigned char* lds = (LAS unsigned char*)lds_raw;
    const int tid = threadIdx.x, lane = tid & 63, wave = __builtin_amdgcn_readfirstlane(tid >> 6);
    const int G = gridDim.x, bx = blockIdx.x, vcu = (G % 8 == 0) ? (bx % 8) * (G / 8) + bx / 8 : bx;
    const float* x = P.in[0];
    volatile LAS unsigned* xst = (volatile LAS unsigned*)(lds + XCH_OFF + 8192);
    if (tid < 4) xst[tid] = 0u;
    __syncthreads();
    const XcdBarrier xbar = xcd_barrier_post((unsigned*)P.ws, xst);


    {
        LAS float* scr = (LAS float*)(lds + wave * 16384);
        const int gw = vcu * NWAVES + wave, NGW = G * NWAVES;
        constexpr int I_IN = 16 * 160, I_BR = 8 * 32, I_OUT = 16 * 32, I_UP = 16 * 176, I_DN = 44 * 32, NITEMS = I_IN + 2 * I_BR + I_OUT + I_UP + I_DN;
        for (int it = gw; it < NITEMS; it += NGW) {
            int r = it;
            if (r < I_IN) { const int kb = r / 160, nb = r % 160, pn = nb >> 3, c32 = nb & 7;
                const int lg = pn < 12 ? (pn >> 1) * 512 + ((pn & 1) * 4 + (c32 & 3)) * 64 + 32 * (c32 >> 2) : 3080 + (c32 >> 2) * 1024 + (pn - 12) * 128 + 32 * (c32 & 3);
                const bool f8t = ((pn >= 2 && pn <= 5) || pn >= 12);
                if (!f8t) tr_item(P.in[2], NCOL_IN, 64 * kb, lg, WT_IN, 1024, 256 * (pn < 2 ? pn : pn - 4) + 32 * c32, 0, nullptr, scr, lane);
                else tr_item8(P.in[2], NCOL_IN, 64 * kb, lg, WT_IN8, 1024, 256 * (pn < 6 ? pn - 2 : pn - 8) + 32 * c32, 64.0f, scr, lane);
                continue; } r -= I_IN;
            if (r < I_BR) { tr_item(P.in[9], 1024, 64 * (r / 32), 32 * (r % 32), WT_BR, 1024, 32 * (r % 32), 0, nullptr, scr, lane); continue; } r -= I_BR;
            if (r < I_BR) { tr_item(P.in[10], 1024, 64 * (r / 32), 32 * (r % 32), WT_BR, 1024, 32 * (r % 32), 512, nullptr, scr, lane); continue; } r -= I_BR;
            if (r < I_OUT) { tr_item(P.in[11], 1024, 64 * (r / 32), 32 * (r % 32), WT_OUT, 1024, 32 * (r % 32), 0, nullptr, scr, lane); continue; } r -= I_OUT;
            if (r < I_UP) { const int kb = r / 176, nb = r % 176, pn = nb >> 3, c32 = nb & 7;
                const int lg = c32 < 4 ? 128 * pn + 32 * c32 : DFF + 128 * pn + 32 * (c32 - 4);
                tr_item(P.in[13], 2 * DFF, 64 * kb, lg, WT_UP, 1024, 32 * nb, 0, P.in[12], scr, lane); continue; } r -= I_UP;
            tr_item(P.in[16], 1024, 64 * (r / 32), 32 * (r % 32), WT_DN, DFF, 32 * (r % 32), 0, nullptr, scr, lane);
        }
        {
            const float invf[8] = {1.0f, 0.19392274474868576f, 0.03760603093086393f, 0.007292664737217109f, 0.001414213562373095f, 0.0002742481756762073f, 5.318295896944988e-05f, 1.031338537721246e-05f};
            for (int id = (vcu * 512 + tid); id < SEQ * 8; id += G * 512) { const int pos = id >> 3, i = id & 7;
                float fi = invf[0];
#pragma unroll
                for (int q = 1; q < 8; ++q) fi = (i == q) ? invf[q] : fi;
                const float ang = (float)pos * fi; const double rev = (double)ang * 0.15915494309189535; const float fr = (float)(rev - __builtin_rint(rev));
                ROPE[pos * 16 + i] = __builtin_amdgcn_cosf(fr); ROPE[pos * 16 + 8 + i] = __builtin_amdgcn_sinf(fr); }
        }
        if (bx == 0 && tid < 256) GAINS[tid] = P.in[5 + (tid >> 6)][tid & 63];
        __syncthreads();
        LAS float* WfT = (LAS float*)lds;
        for (int idx = tid; idx < 8192; idx += 512) { const int k = idx >> 3, j = idx & 7; WfT[j * 1024 + k] = P.in[2][(size_t)k * NCOL_IN + 3072 + j]; }
        __syncthreads();
        f32x4 gv[4];
#pragma unroll
        for (int j = 0; j < 4; ++j) gv[j] = ((const f32x4*)P.in[1])[lane + 64 * j];
        const float bfg = P.in[3][lane & 7];
        f32x4 nv[4];
        if (gw < TOK) { const f32x4* xr = (const f32x4*)(x + (size_t)gw * DM) + lane;
#pragma unroll
            for (int j = 0; j < 4; ++j) nv[j] = xr[64 * j]; }
        for (int row = gw; row < TOK; row += NGW) {
            f32x4 v[4]; float ss = 0.f;
#pragma unroll
            for (int j = 0; j < 4; ++j) v[j] = nv[j];
            if (row + NGW < TOK) { const f32x4* xr = (const f32x4*)(x + (size_t)(row + NGW) * DM) + lane;
#pragma unroll
                for (int j = 0; j < 4; ++j) nv[j] = xr[64 * j]; }
#pragma unroll
            for (int j = 0; j < 4; ++j) ss += (v[j][0] * v[j][0] + v[j][1] * v[j][1]) + (v[j][2] * v[j][2] + v[j][3] * v[j][3]);
            const float rn = 1.0f / sqrtf(wave_sum(ss) * (1.0f / DM) + NORM_EPS);
            v2u* o8 = (v2u*)(H + (size_t)row * DM) + lane;
#pragma unroll
            for (int j = 0; j < 4; ++j) { v[j] = v[j] * rn * gv[j]; v2u o; o.x = pk2(v[j][0], v[j][1]); o.y = pk2(v[j][2], v[j][3]); o8[64 * j] = o;
                int w8 = __builtin_amdgcn_cvt_pk_fp8_f32(v[j][0], v[j][1], 0, false); w8 = __builtin_amdgcn_cvt_pk_fp8_f32(v[j][2], v[j][3], w8, true);
                ((unsigned*)(H8 + (size_t)row * DM))[lane + 64 * j] = (unsigned)w8; }
            float mine = 0.f;
#pragma unroll
            for (int jj = 0; jj < 8; ++jj) { float a = 0.f;
#pragma unroll
                for (int j = 0; j < 4; ++j) { const f32x4 wv = *(const LAS f32x4*)(WfT + jj * 1024 + 4 * lane + 256 * j); a += (v[j][0] * wv[0] + v[j][1] * wv[1]) + (v[j][2] * wv[2] + v[j][3] * wv[3]); }
                a = wave_sum(a); if (lane == jj) mine = a; }
            if (lane < 8) { const float z = mine + bfg; const float ls = fminf(z, 0.f) - __logf(1.0f + __expf(-fabsf(z))); LOGF[((size_t)(row >> 12) * 8 + lane) * SEQ + (row & (SEQ - 1))] = ls; }
        }
    }
    if (P.ws == nullptr) GSYNC();
    XSYNC();


    for (int bh = bx; bh < 128; bh += G) {
        LAS float* wt = (LAS float*)lds;
        const float* lf = LOGF + (size_t)bh * SEQ + 8 * tid; const f32x4 a = *(const f32x4*)lf, c = *(const f32x4*)(lf + 4);
        float pf[8]; pf[0] = a[0]; pf[1] = pf[0] + a[1]; pf[2] = pf[1] + a[2]; pf[3] = pf[2] + a[3]; pf[4] = pf[3] + c[0]; pf[5] = pf[4] + c[1]; pf[6] = pf[5] + c[2]; pf[7] = pf[6] + c[3];
        float xs = pf[7];
#pragma unroll
        for (int o = 1; o < 64; o <<= 1) { const float y = __shfl_up(xs, o); if (lane >= o) xs += y; }
        if (lane == 63) wt[wave] = xs;
        __syncthreads();
        float off = xs - pf[7];
        for (int q = 0; q < wave; ++q) off += wt[q];
        float* cp = CL + (size_t)bh * SEQ + 8 * tid;
        *(f32x4*)cp = (f32x4){(off + pf[0]) * LOG2E, (off + pf[1]) * LOG2E, (off + pf[2]) * LOG2E, (off + pf[3]) * LOG2E};
        *(f32x4*)(cp + 4) = (f32x4){(off + pf[4]) * LOG2E, (off + pf[5]) * LOG2E, (off + pf[6]) * LOG2E, (off + pf[7]) * LOG2E};
        __syncthreads();
    }
    {
        {
            pg8::Gemm g{H, WT_IN, TOK, 2048, 1024}; pg8::StaticOrder S; S.init(TOK, 2048, G, bx);
            pg8::EpiG1 E{QA, GATES, KMP, 0, 1.0f, GAINS, P.in[4], ROPE};
            GEMM_PHASE(pg8::EpiG1);
        }
        {
            pg8::Gemm g{(const pg8::bf16_t*)H8, (const pg8::bf16_t*)WT_IN8, TOK, 3072, 1024}; pg8::StaticOrder S; S.init(TOK, 3072, G, bx);
            pg8::EpiG1 E{QA, GATES, KMP, 4, 1.0f / 64.0f, GAINS, P.in[4], ROPE};
            pg8::gemm_phase<pg8::EpiG1, pg8::StaticOrder, true, true, true>(lds, g, S, E);
        }
    }
    XSYNC();


    {
        float mq = fabsf(P.in[7][lane]), mk = fabsf(P.in[8][lane]);
#pragma unroll
        for (int o = 1; o < 64; o <<= 1) { mq = fmaxf(mq, __shfl_xor(mq, o)); mk = fmaxf(mk, __shfl_xor(mk, o)); }
        const float qk2max = 64.0f * QSCALE * mq * mk * 1.02f;
        float mqa = fabsf(P.in[5][lane]), mka = fabsf(P.in[6][lane]);
#pragma unroll
        for (int o = 1; o < 64; o <<= 1) { mqa = fmaxf(mqa, __shfl_xor(mqa, o)); mka = fmaxf(mka, __shfl_xor(mka, o)); }
        const float qk2max_a = 64.0f * QSCALE * mqa * mka * 1.02f;
        const att::Tens T{QA, KA, VTA, QB, KB, VTB, OB, KMP, CL};
        if (wave >= 4) __builtin_amdgcn_s_setprio(1);
        for (int v = vcu; v < 256; v += G) {
            const int bh = v >> 1, par = v & 1;
            {
                LAS float* KMl = (LAS float*)(lds + att::L_KM);
                for (int idx = tid; idx < 1024; idx += 512) { const int n = idx >> 6, d = idx & 63; const float* kp = KMP + ((size_t)(bh * 16 + n) * 2) * 64 + d; KMl[idx] = (kp[0] + kp[64]) * (1.0f / 256.0f); }
                __syncthreads();
            }
            for (int i = 0; i < 8; ++i) { const int s = 4 * par + (i & 3); att::unit<false>(lds, T, bh, i < 4 ? 15 - s : s, qk2max, qk2max_a); }
            for (int i = 0; i < 8; ++i) att::unit<true>(lds, T, bh, 8 * par + i, qk2max, qk2max_a);
        }
        __builtin_amdgcn_s_setprio(0);
    }
    XSYNC();

    {
        pg8::Gemm g{OB, WT_BR, TOK, 1024, 1024}; pg8::StaticOrder S; S.init(TOK, 1024, G, bx);
        pg8::EpiG2 E{GATES, MERGED};
        GEMM_PHASE(pg8::EpiG2);
    }
    XSYNC();
    {
        pg8::Gemm g{MERGED, WT_OUT, TOK, 1024, 1024}; pg8::StaticOrder S; S.init(TOK, 1024, G, bx);
        pg8::EpiG3 E{x, P.out, X1B, SSQ};
        GEMM_PHASE(pg8::EpiG3);
    }
    XSYNC();
    {
        pg8::Gemm g{X1B, WT_UP, TOK, 2 * DFF, 1024}; pg8::StaticOrder S; S.init(TOK, 2 * DFF, G, bx);
        pg8::EpiG4 E{SSQ, P.in[14], P.in[15], ACT, G01, U01, GT, (LAS float*)(lds + XCH_OFF)};
        GEMM_PHASE(pg8::EpiG4);
    }
    XSYNC();
    {
        const float* cw = P.in[14]; const float* cb = P.in[15];
        for (int idx = bx * 512 + tid; idx < 256 * 2 * (DFF / 4); idx += G * 512) {
            const int f = 4 * (idx % (DFF / 4)), j = (idx / (DFF / 4)) & 1, pm = idx / (2 * (DFF / 4));
            if ((pm & 15) == 0) continue;
            const f32x4 g0 = *(const f32x4*)(G01 + ((size_t)pm * 2 + 0) * DFF + f), g1 = *(const f32x4*)(G01 + ((size_t)pm * 2 + 1) * DFF + f);
            const f32x4 gm2 = *(const f32x4*)(GT + ((size_t)(pm - 1) * 2 + 0) * DFF + f), gm1 = *(const f32x4*)(GT + ((size_t)(pm - 1) * 2 + 1) * DFF + f);
            const f32x4 uu = *(const f32x4*)(U01 + ((size_t)pm * 2 + j) * DFF + f);
            const f32x4 w0 = *(const f32x4*)(cw + f), w1 = *(const f32x4*)(cw + DFF + f), w2 = *(const f32x4*)(cw + 2 * DFF + f), bb = *(const f32x4*)(cb + f);
            const f32x4 cv = (j == 0) ? (w0 * gm2 + w1 * gm1 + w2 * g0 + bb) : (w0 * gm1 + w1 * g0 + w2 * g1 + bb);
            f32x4 a;
#pragma unroll
            for (int e = 0; e < 4; ++e) a[e] = cv[e] * pg8::sigm(cv[e]) * uu[e];
            v2u o; o.x = pk2(a[0], a[1]); o.y = pk2(a[2], a[3]);
            *(v2u*)(ACT + ((size_t)pm * 256 + j) * DFF + f) = o;
        }
    }
    XSYNC();
    {
        pg8::Gemm g{ACT, WT_DN, TOK, 1024, DFF}; pg8::StaticOrder S; S.init(TOK, 1024, G, bx);
        pg8::EpiG5 E{P.out, X1B};
        GEMM_PHASE(pg8::EpiG5);
    }
}

extern "C" void kernel_launch(void* const* d_in, const int* in_sizes, int n_in, void* d_out, int out_size, void* d_ws, size_t ws_size, hipStream_t stream) {
    static int grid = 0;
    if (grid == 0) {
        if (n_in != 17 || in_sizes[0] != TOK * DM || out_size != TOK * DM || ws_size < WS_END) { fprintf(stderr, "kernel_launch: unexpected shapes / workspace (n_in %d, ws %zu)\n", n_in, ws_size); grid = -1; return; }
        int dev = 0, cus = 0, per_cu = 0;
        hipGetDevice(&dev); hipDeviceGetAttribute(&cus, hipDeviceAttributeMultiprocessorCount, dev);
        if (hipFuncSetAttribute((const void*)fwd, hipFuncAttributeMaxDynamicSharedMemorySize, LDS_BYTES) != hipSuccess) { fprintf(stderr, "kernel_launch: hipFuncSetAttribute failed\n"); grid = -1; return; }
        if (hipOccupancyMaxActiveBlocksPerMultiprocessor(&per_cu, (const void*)fwd, 512, LDS_BYTES) != hipSuccess || per_cu < 1) { fprintf(stderr, "kernel_launch: occupancy query says %d\n", per_cu); per_cu = 1; }
        (void)hipGetLastError();
        grid = cus * per_cu;
    }
    if (grid < 0) return;
    if (hipMemsetAsync(d_ws, 0, 16384, stream) != hipSuccess) { fprintf(stderr, "kernel_launch: memset of the barrier words failed\n"); return; }
    Params p{};
    for (int i = 0; i < 17; ++i) p.in[i] = (const float*)d_in[i];
    p.out = (float*)d_out; p.ws = (unsigned char*)d_ws;
    void* args[] = {&p};
    hipError_t e = hipLaunchCooperativeKernel((const void*)fwd, dim3(grid), dim3(512), args, LDS_BYTES, stream);
    if (e != hipSuccess) fprintf(stderr, "cooperative launch failed: %s (grid %d)\n", hipGetErrorString(e), grid);
}
```

```cpp
#include <hip/hip_runtime.h>
#include <hip/hip_cooperative_groups.h>
#include <cstdio>
#include <cstdint>
namespace cg = cooperative_groups;
constexpr int TOK = 65536, SEQ = 4096, DM = 1024, DFF = 2816, NCOL_IN = 5128;
constexpr float LOG2E = 1.4426950408889634f;
constexpr float QSCALE = 0.125f * 1.4426950408889634f;
constexpr float NORM_EPS = 1e-6f;
namespace pg8 {
#define PG8_LAS __attribute__((address_space(3)))
typedef unsigned short bf16_t;
typedef short bf16x8 __attribute__((ext_vector_type(8)));
typedef float f32x4 __attribute__((ext_vector_type(4)));
typedef unsigned u32x4 __attribute__((ext_vector_type(4)));
constexpr int BM = 256, BK = 64, HALF = 128, HTB = HALF * BK * 2  , STAGE_BYTES = 8 * HTB, NXCD = 8, WGM = 8;

__host__ __device__ __forceinline__ int lds_byte(int r, int c) { const int st = (r >> 4) * 2 + (c >> 5), rr = r & 15, cc = c & 31, ob = rr * 64 + cc * 2; return st * 1024 + (ob ^ (((ob >> 9) & 1) << 5)); }
__host__ __device__ __forceinline__ void stage_rc(int b, int& R, int& C) { const int st = b / 1024, sb = b % 1024, swz = sb ^ (((sb >> 9) & 1) << 5); R = (st >> 1) * 16 + swz / 64; C = (st & 1) * 32 + (swz % 64) / 2; }
__host__ __device__ __forceinline__ int perm32(int rho) { const int n = rho >> 4, i = rho & 15; return 8 * (i >> 2) + 4 * n + (i & 3); }

struct Unit { int pm, pn; };
struct Gemm { const bf16_t* A; const bf16_t* Bt; int M, N, K; };

struct StaticOrder {
    int nM, nN, nwg, G, c;
    __host__ __device__ void init(int M, int N, int G_, int c_) { nM = M / BM; nN = N / BM; nwg = nM * nN; G = G_; c = c_; }
    __host__ __device__ bool next(int i, Unit& u) const {
        const long L = (long)i * G + c; if (L >= nwg) return false;
        int wgid = (int)L; { const int q = nwg / NXCD, r = nwg % NXCD, xcd = wgid % NXCD, off = wgid / NXCD; wgid = (xcd < r ? xcd * (q + 1) : r * (q + 1) + (xcd - r) * q) + off; }
        const int nig = WGM * nN, gid = wgid / nig, fm = gid * WGM, gsz = (nM - fm) < WGM ? (nM - fm) : WGM;
        u.pm = fm + ((wgid % nig) % gsz); u.pn = (wgid % nig) / gsz; return true;
    }
    __device__ __forceinline__ void a_ready(const Unit&) const {}
    __device__ __forceinline__ void done(const Unit&) const {}
};

typedef float f32x2_t __attribute__((ext_vector_type(2))); typedef __bf16 bf16x2_t __attribute__((ext_vector_type(2)));
__device__ __forceinline__ unsigned cvt_pk_bf16(float lo, float hi) { f32x2_t v = {lo, hi}; bf16x2_t b = __builtin_convertvector(v, bf16x2_t); return __builtin_bit_cast(unsigned, b); }
__device__ __forceinline__ float sigm(float z) { return __builtin_amdgcn_rcpf(1.f + __builtin_amdgcn_exp2f(-z * LOG2E)); }
__device__ __forceinline__ float bflo(unsigned w) { return __uint_as_float(w << 16); }
__device__ __forceinline__ float bfhi(unsigned w) { return __uint_as_float(w & 0xffff0000u); }
#define PG8_EPI_BAR() asm volatile("s_waitcnt lgkmcnt(0)\n\ts_barrier" ::: "memory")

struct EpiG1 {
    static constexpr bool PERM = true, AFTER_DRAIN = false, MID = false;
    bf16_t *QKV, *GATES; float* KMP;
    int pn_base; float us;
    const float *gains, *bgate, *rope;
    __device__ __forceinline__ void mid(f32x4 (&acc)[2][2][4][2], const Unit& u, int wr, int wc, int fr, int fq) const {}
    __device__ __forceinline__ void operator()(f32x4 (&acc)[2][2][4][2], const Unit& u, int wr, int wc, int fr, int fq) const {
        int pn = pn_base == 0 ? (u.pn < 2 ? u.pn : u.pn + 4) : (u.pn < 4 ? u.pn + 2 : u.pn + 8), pm = u.pm;
        int rowt = pm * BM + wr * 64 + fr; asm volatile("" : "+v"(rowt));
        if (pn >= 12) {
            const int t = pn - 12, colb = t * 128 + wc * 32 + 8 * fq;
            const int gtid = (wr * 4 + wc) * 64 + fq * 16 + fr;
            f32x4 bv[2][2];
#pragma unroll
            for (int bj = 0; bj < 2; ++bj)
#pragma unroll
                for (int n = 0; n < 2; ++n) bv[bj][n] = *(const f32x4*)(bgate + bj * 1024 + colb + 4 * n);
#pragma unroll
            for (int ai = 0; ai < 2; ++ai)
#pragma unroll
                for (int m = 0; m < 4; ++m) { bf16_t* rowp = GATES + ((((size_t)(pm * 8 + t) * 8 + (ai * 4 + m)) * 512 + gtid) * 8);
                    f32x4 rr[2], gg[2];
#pragma unroll
                    for (int n = 0; n < 2; ++n) { const f32x4 z0 = acc[ai][0][m][n] * us + bv[0][n], z1 = acc[ai][1][m][n] * us + bv[1][n];
#pragma unroll
                        for (int e = 0; e < 4; ++e) { const float e0 = fminf(__builtin_amdgcn_exp2f(-z0[e] * LOG2E), 1e30f), e1 = fminf(__builtin_amdgcn_exp2f(-z1[e] * LOG2E), 1e30f);
                            gg[n][e] = __builtin_amdgcn_rcpf(1.f + e1); rr[n][e] = (1.f + e1) * __builtin_amdgcn_rcpf(1.f + e0); } }
                    u32x4 w; w.x = cvt_pk_bf16(rr[0][0], rr[0][1]); w.y = cvt_pk_bf16(rr[0][2], rr[0][3]); w.z = cvt_pk_bf16(rr[1][0], rr[1][1]); w.w = cvt_pk_bf16(rr[1][2], rr[1][3]);
                    *(u32x4*)rowp = w;
                    u32x4 v; v.x = cvt_pk_bf16(gg[0][0], gg[0][1]); v.y = cvt_pk_bf16(gg[0][2], gg[0][3]); v.z = cvt_pk_bf16(gg[1][0], gg[1][1]); v.w = cvt_pk_bf16(gg[1][2], gg[1][3]);
                    *(u32x4*)(rowp + (size_t)TOK * 1024) = v; }
            return;
        }
        const int sect = pn >> 1, head = (pn & 1) * 4 + wc, b = pm >> 4;
        if (sect == 2 || sect == 5) {
            bf16_t* vb = QKV + (size_t)sect * TOK * 512 + (size_t)(b * 8 + head) * 64 * SEQ;
            const int slot = ((fr >> 2) & 1) * 8 + ((fr >> 3) & 1) * 4 + (fr & 3);
            const int s0 = (pm & 15) * 256 + wr * 64 + slot;
#pragma unroll
            for (int ai = 0; ai < 2; ++ai)
#pragma unroll
                for (int m = 0; m < 4; ++m) { bf16_t* sp = vb + s0 + ai * HALF + m * 16;
#pragma unroll
                    for (int bj = 0; bj < 2; ++bj)
#pragma unroll
                        for (int n = 0; n < 2; ++n) { const f32x4 x = acc[ai][bj][m][n] * us; const unsigned w0 = cvt_pk_bf16(x[0], x[1]), w1 = cvt_pk_bf16(x[2], x[3]); const int d = 32 * bj + 8 * fq + 4 * n;
                            sp[(size_t)(d + 0) * SEQ] = (bf16_t)(w0 & 0xffffu); sp[(size_t)(d + 1) * SEQ] = (bf16_t)(w0 >> 16);
                            sp[(size_t)(d + 2) * SEQ] = (bf16_t)(w1 & 0xffffu); sp[(size_t)(d + 3) * SEQ] = (bf16_t)(w1 >> 16); } }
            return;
        }
        const bool isA = sect < 2, isK = (sect == 1 || sect == 4);
        const float* gain = gains + (sect < 2 ? sect : sect - 1) * 64;
        bf16_t* dst = QKV + (size_t)sect * TOK * 512;
        const float qs = isK ? 1.f : QSCALE;
        f32x4 gv[2][2], csum[2][2];
#pragma unroll
        for (int bj = 0; bj < 2; ++bj)
#pragma unroll
            for (int n = 0; n < 2; ++n) { gv[bj][n] = *(const f32x4*)(gain + 32 * bj + 8 * fq + 4 * n) * qs; csum[bj][n] = (f32x4){0.f, 0.f, 0.f, 0.f}; }
#pragma unroll
        for (int ai = 0; ai < 2; ++ai)
#pragma unroll
            for (int m = 0; m < 4; ++m) {
                const int row = rowt + ai * HALF + m * 16;
                float ss = 0.f;
#pragma unroll
                for (int bj = 0; bj < 2; ++bj)
#pragma unroll
                    for (int n = 0; n < 2; ++n) { const f32x4 x = acc[ai][bj][m][n]; ss += (x[0] * x[0] + x[1] * x[1]) + (x[2] * x[2] + x[3] * x[3]); }
                ss += __shfl_xor(ss, 16); ss += __shfl_xor(ss, 32);
                const float rn = __builtin_amdgcn_rsqf(ss * (us * us * (1.0f / 64.0f)) + NORM_EPS) * us;
                f32x4 v[2][2];
#pragma unroll
                for (int bj = 0; bj < 2; ++bj)
#pragma unroll
                    for (int n = 0; n < 2; ++n) v[bj][n] = acc[ai][bj][m][n] * rn * gv[bj][n];
                if (isA) {
                    const int pos = row & (SEQ - 1);
#pragma unroll
                    for (int n = 0; n < 2; ++n) {
                        f32x4 cs = (f32x4){1.f, 1.f, 1.f, 1.f}, sn = (f32x4){0.f, 0.f, 0.f, 0.f};
                        if (fq < 2) { cs = *(const f32x4*)(rope + pos * 16 + 4 * n); sn = *(const f32x4*)(rope + pos * 16 + 8 + 4 * n); }
                        if (fq == 0) sn = -sn;
#pragma unroll
                        for (int e = 0; e < 4; ++e) { const float o = __shfl_xor(v[0][n][e], 16); v[0][n][e] = v[0][n][e] * cs[e] + o * sn[e]; }
                    }
                }
#pragma unroll
                for (int bj = 0; bj < 2; ++bj) { u32x4 w; w.x = cvt_pk_bf16(v[bj][0][0], v[bj][0][1]); w.y = cvt_pk_bf16(v[bj][0][2], v[bj][0][3]); w.z = cvt_pk_bf16(v[bj][1][0], v[bj][1][1]); w.w = cvt_pk_bf16(v[bj][1][2], v[bj][1][3]);
                    *(u32x4*)(dst + (size_t)row * 512 + head * 64 + 32 * bj + 8 * fq) = w; }
                if (sect == 1) {
#pragma unroll
                    for (int bj = 0; bj < 2; ++bj)
#pragma unroll
                        for (int n = 0; n < 2; ++n) csum[bj][n] += v[bj][n];
                }
            }
        if (sect == 1) {
#pragma unroll
            for (int bj = 0; bj < 2; ++bj)
#pragma unroll
                for (int n = 0; n < 2; ++n) { f32x4 x = csum[bj][n];
#pragma unroll
                    for (int e = 0; e < 4; ++e) { float y = x[e]; y += __shfl_xor(y, 1); y += __shfl_xor(y, 2); y += __shfl_xor(y, 4); y += __shfl_xor(y, 8); x[e] = y; }
                    if (fr == 0) *(f32x4*)(KMP + ((size_t)((b * 8 + head) * 16 + (pm & 15)) * 2 + wr) * 64 + 32 * bj + 8 * fq + 4 * n) = x; }
        }
    }
};

struct EpiG2 {
    static constexpr bool PERM = true, AFTER_DRAIN = false, MID = true;
    const bf16_t* GATES; bf16_t* MERGED;
    __device__ __forceinline__ void mid(f32x4 (&acc)[2][2][4][2], const Unit& u, int wr, int wc, int fr, int fq) const {
        asm volatile("" : "+v"(fq)); int rowt = u.pm * BM + wr * 64 + fr; asm volatile("" : "+v"(rowt));
        const int colb = u.pn * BM + wc * 32 + 8 * fq; const int gtid = (wr * 4 + wc) * 64 + fq * 16 + fr;
        u32x4 a[2][4][2];
#pragma unroll
        for (int ai = 0; ai < 2; ++ai)
#pragma unroll
            for (int m = 0; m < 4; ++m)
#pragma unroll
                for (int bj = 0; bj < 2; ++bj) a[ai][m][bj] = *(const u32x4*)(GATES + ((((size_t)(u.pm * 8 + 2 * u.pn + bj) * 8 + (ai * 4 + m)) * 512 + gtid) * 8));
#pragma unroll
        for (int ai = 0; ai < 2; ++ai)
#pragma unroll
            for (int m = 0; m < 4; ++m)
#pragma unroll
                for (int bj = 0; bj < 2; ++bj) { const u32x4 c = a[ai][m][bj];
                    acc[ai][bj][m][0] *= (f32x4){bflo(c.x), bfhi(c.x), bflo(c.y), bfhi(c.y)}; acc[ai][bj][m][1] *= (f32x4){bflo(c.z), bfhi(c.z), bflo(c.w), bfhi(c.w)}; }
    }
    __device__ __forceinline__ void operator()(f32x4 (&acc)[2][2][4][2], const Unit& u, int wr, int wc, int fr, int fq) const {
        asm volatile("" : "+v"(fq)); int rowt = u.pm * BM + wr * 64 + fr; asm volatile("" : "+v"(rowt));
        const int colb = u.pn * BM + wc * 32 + 8 * fq; const int gtid = (wr * 4 + wc) * 64 + fq * 16 + fr;
#pragma unroll
        for (int ai = 0; ai < 2; ++ai)
#pragma unroll
            for (int m = 0; m < 4; ++m) { const size_t off = (size_t)(rowt + ai * HALF + m * 16) * 1024 + colb;
#pragma unroll
                for (int bj = 0; bj < 2; ++bj) { const u32x4 c = *(const u32x4*)(GATES + (size_t)TOK * 1024 + ((((size_t)(u.pm * 8 + 2 * u.pn + bj) * 8 + (ai * 4 + m)) * 512 + gtid) * 8));
                    const f32x4 v0 = acc[ai][bj][m][0] * (f32x4){bflo(c.x), bfhi(c.x), bflo(c.y), bfhi(c.y)}, v1 = acc[ai][bj][m][1] * (f32x4){bflo(c.z), bfhi(c.z), bflo(c.w), bfhi(c.w)};
                    u32x4 w; w.x = cvt_pk_bf16(v0[0], v0[1]); w.y = cvt_pk_bf16(v0[2], v0[3]); w.z = cvt_pk_bf16(v1[0], v1[1]); w.w = cvt_pk_bf16(v1[2], v1[3]);
                    *(u32x4*)(MERGED + off + bj * HALF) = w; }
                if (m == 3) asm volatile("" ::: "memory"); }
    }
};

struct EpiG3 {
    static constexpr bool PERM = true, AFTER_DRAIN = false, MID = false;
    const float* X; float* OUT; bf16_t* X1B; float* SSQ;
    __device__ __forceinline__ void mid(f32x4 (&acc)[2][2][4][2], const Unit& u, int wr, int wc, int fr, int fq) const {}
    __device__ __forceinline__ void operator()(f32x4 (&acc)[2][2][4][2], const Unit& u, int wr, int wc, int fr, int fq) const {
        asm volatile("" : "+v"(fq)); int rowt = u.pm * BM + wr * 64 + fr; asm volatile("" : "+v"(rowt));
        const int colb = u.pn * BM + wc * 32 + 8 * fq;
#pragma unroll
        for (int ai = 0; ai < 2; ++ai)
#pragma unroll
            for (int m = 0; m < 4; ++m) { const int row = rowt + ai * HALF + m * 16; const size_t off = (size_t)row * 1024 + colb; float ss = 0.f;
#pragma unroll
                for (int bj = 0; bj < 2; ++bj) { const f32x4 x0 = *(const f32x4*)(X + off + bj * HALF), x1 = *(const f32x4*)(X + off + bj * HALF + 4);
                    const f32x4 v0 = acc[ai][bj][m][0] + x0, v1 = acc[ai][bj][m][1] + x1;
                    u32x4 w; w.x = cvt_pk_bf16(v0[0], v0[1]); w.y = cvt_pk_bf16(v0[2], v0[3]); w.z = cvt_pk_bf16(v1[0], v1[1]); w.w = cvt_pk_bf16(v1[2], v1[3]);
                    *(u32x4*)(X1B + off + bj * HALF) = w;
                    ss += ((v0[0] * v0[0] + v0[1] * v0[1]) + (v0[2] * v0[2] + v0[3] * v0[3])) + ((v1[0] * v1[0] + v1[1] * v1[1]) + (v1[2] * v1[2] + v1[3] * v1[3])); }
                ss += __shfl_xor(ss, 16); ss += __shfl_xor(ss, 32);
                if (fq == 0) SSQ[(size_t)row * 16 + u.pn * 4 + wc] = ss;
                asm volatile("" ::: "memory"); }
    }
};

struct EpiG4 {
    static constexpr bool PERM = true, AFTER_DRAIN = false, MID = false;
    const float *SSQ, *cw, *cb; bf16_t* ACT; float *G01, *U01, *GT; PG8_LAS float* xch;
    __device__ __forceinline__ void mid(f32x4 (&acc)[2][2][4][2], const Unit& u, int wr, int wc, int fr, int fq) const {}
    __device__ __forceinline__ void operator()(f32x4 (&acc)[2][2][4][2], const Unit& u, int wr, int wc, int fr, int fq) const {
        int pm = u.pm, pn = u.pn; asm volatile("" : "+s"(pn), "+s"(pm)); asm volatile("" : "+v"(fq), "+v"(fr)); const int lane = fr + 16 * fq;
        int rowt = pm * BM + wr * 64 + fr; asm volatile("" : "+v"(rowt));
        const int fcol = pn * 128 + wc * 32 + 8 * fq, lcol = wc * 32 + 8 * fq;
#pragma unroll
        for (int ai = 0; ai < 2; ++ai)
#pragma unroll
            for (int m = 0; m < 4; ++m) { const f32x4 p = *(const f32x4*)(SSQ + (size_t)(rowt + ai * HALF + m * 16) * 16 + 4 * fq);
                float s = (p[0] + p[1]) + (p[2] + p[3]); s += __shfl_xor(s, 16); s += __shfl_xor(s, 32);
                const float r2 = __builtin_amdgcn_rsqf(s * (1.0f / 1024.0f) + NORM_EPS);
#pragma unroll
                for (int bj = 0; bj < 2; ++bj)
#pragma unroll
                    for (int n = 0; n < 2; ++n) acc[ai][bj][m][n] *= r2; }
        if (fr >= 14) {
#pragma unroll
            for (int ai = 0; ai < 2; ++ai)
#pragma unroll
                for (int n = 0; n < 2; ++n) *(PG8_LAS f32x4*)(xch + ((ai * 2 + wr) * 2 + (fr - 14)) * 128 + lcol + 4 * n) = acc[ai][1][3][n];
            if (wr == 1) {
#pragma unroll
                for (int n = 0; n < 2; ++n) *(f32x4*)(GT + ((size_t)pm * 2 + (fr - 14)) * DFF + fcol + 4 * n) = acc[1][1][3][n];
            }
        }
        if (fr < 2 && wr == 0) {
#pragma unroll
            for (int n = 0; n < 2; ++n) { *(f32x4*)(G01 + ((size_t)pm * 2 + fr) * DFF + fcol + 4 * n) = acc[0][1][0][n]; *(f32x4*)(U01 + ((size_t)pm * 2 + fr) * DFF + fcol + 4 * n) = acc[0][0][0][n]; }
        }
        PG8_EPI_BAR();
        f32x4 w0[2], w1[2], w2[2], bb[2];
#pragma unroll
        for (int n = 0; n < 2; ++n) { w0[n] = *(const f32x4*)(cw + fcol + 4 * n); w1[n] = *(const f32x4*)(cw + DFF + fcol + 4 * n); w2[n] = *(const f32x4*)(cw + 2 * DFF + fcol + 4 * n); bb[n] = *(const f32x4*)(cb + fcol + 4 * n); }
        const int src1 = (lane & 48) | ((fr + 15) & 15), src2 = (lane & 48) | ((fr + 14) & 15);
#pragma unroll
        for (int ai = 0; ai < 2; ++ai) {
            f32x4 l1[2], l2[2];
            {
                const bool has = (wr == 1) || (ai == 1);
                const int pidx = (wr == 1) ? (ai * 2 + 0) : (0 * 2 + 1);
#pragma unroll
                for (int n = 0; n < 2; ++n) {
                    f32x4 h0 = (f32x4){0.f, 0.f, 0.f, 0.f}, h1 = (f32x4){0.f, 0.f, 0.f, 0.f};
                    if (has) { h0 = *(const PG8_LAS f32x4*)(xch + (pidx * 2 + 0) * 128 + lcol + 4 * n); h1 = *(const PG8_LAS f32x4*)(xch + (pidx * 2 + 1) * 128 + lcol + 4 * n); }
                    l1[n] = h1; l2[n] = (fr == 0) ? h0 : h1;
                }
            }
#pragma unroll
            for (int m = 0; m < 4; ++m) {
                bf16_t* op = ACT + (size_t)(rowt + ai * HALF + m * 16) * DFF + fcol;
                u32x4 w;
#pragma unroll
                for (int n = 0; n < 2; ++n) {
                    const f32x4 cur = acc[ai][1][m][n], uu = acc[ai][0][m][n];
                    f32x4 p1, p2;
#pragma unroll
                    for (int e = 0; e < 4; ++e) { p1[e] = __shfl(cur[e], src1); p2[e] = __shfl(cur[e], src2); }
                    f32x4 a;
#pragma unroll
                    for (int e = 0; e < 4; ++e) { const float pv1 = (fr >= 1) ? p1[e] : l1[n][e], pv2 = (fr >= 2) ? p2[e] : l2[n][e];
                        const float cv = w0[n][e] * pv2 + w1[n][e] * pv1 + w2[n][e] * cur[e] + bb[n][e];
                        a[e] = cv * sigm(cv) * uu[e]; }
                    l1[n] = p1; l2[n] = p2;
                    if (n == 0) { w.x = cvt_pk_bf16(a[0], a[1]); w.y = cvt_pk_bf16(a[2], a[3]); } else { w.z = cvt_pk_bf16(a[0], a[1]); w.w = cvt_pk_bf16(a[2], a[3]); }
                }
                if (!(ai == 0 && m == 0 && wr == 0 && fr < 2 && (pm & 15) != 0)) *(u32x4*)op = w;
            }
        }
    }
};

struct EpiG5 {
    static constexpr bool PERM = true, AFTER_DRAIN = false, MID = false;
    float* OUT; const bf16_t* X1B;
    __device__ __forceinline__ void mid(f32x4 (&acc)[2][2][4][2], const Unit& u, int wr, int wc, int fr, int fq) const {}
    __device__ __forceinline__ void operator()(f32x4 (&acc)[2][2][4][2], const Unit& u, int wr, int wc, int fr, int fq) const {
        asm volatile("" : "+v"(fq)); int rowt = u.pm * BM + wr * 64 + fr; asm volatile("" : "+v"(rowt));
        const int colb = u.pn * BM + wc * 32 + 8 * fq;
#pragma unroll
        for (int ai = 0; ai < 2; ++ai)
#pragma unroll
            for (int m = 0; m < 4; ++m) { const size_t off = (size_t)(rowt + ai * HALF + m * 16) * 1024 + colb;
#pragma unroll
                for (int bj = 0; bj < 2; ++bj) { float* p = OUT + off + bj * HALF; const u32x4 xb = *(const u32x4*)(X1B + off + bj * HALF);
                    const f32x4 x0 = (f32x4){bflo(xb.x), bfhi(xb.x), bflo(xb.y), bfhi(xb.y)}, x1 = (f32x4){bflo(xb.z), bfhi(xb.z), bflo(xb.w), bfhi(xb.w)};
                    *(f32x4*)p = acc[ai][bj][m][0] + x0; *(f32x4*)(p + 4) = acc[ai][bj][m][1] + x1; }
                asm volatile("" ::: "memory"); }
    }
};
template <class Epi, class Sched, bool ALIGN_EPI = false, bool SP2 = false, bool F8 = false>
__device__ __forceinline__ void gemm_phase(PG8_LAS unsigned char* lds, const Gemm g, const Sched& S, const Epi& E) {
    int tid_ = threadIdx.x; asm volatile("" : "+v"(tid_));
    const int tid = tid_, wid = __builtin_amdgcn_readfirstlane(tid >> 6), lane = tid & 63, wr = wid >> 2, wc = wid & 3, fr = lane & 15, fq = lane >> 4;
    const int K = g.K, nt = F8 ? K / 128 : K / BK;
    unsigned voffA[2], voffB[2];
#pragma unroll
    for (int i = 0; i < 2; ++i) { int R, C; stage_rc(tid * 16 + i * 8192, R, C); const int Rb = Epi::PERM ? ((R & ~31) + perm32(R & 31)) : R;
        voffA[i] = F8 ? (unsigned)(R * K + 2 * C) : (unsigned)(R * K + C) * 2u; voffB[i] = F8 ? (unsigned)(Rb * K + 2 * C) : (unsigned)(Rb * K + C) * 2u; }
    const size_t kstep = (size_t)(BK * 2);
    const size_t hstep = (size_t)HALF * K * (F8 ? 1 : 2);
    const size_t tstep = 2 * hstep;
    const unsigned ldsw = (unsigned)wid * 1024u;
    const int aoff = lds_byte(wr * 64 + fr, F8 ? fq * 16 : fq * 8), boff = lds_byte(wc * 32 + fr, F8 ? fq * 16 : fq * 8);
#define PG8_SA(b, h) (((b) * 2 + (h)) * HTB)
#define PG8_SB(b, h) ((4 + (b) * 2 + (h)) * HTB)
#define PG8_STAGE(bufoff, gbase, voff) do { _Pragma("unroll") for (int _i = 0; _i < 2; ++_i) \
        __builtin_amdgcn_global_load_lds((const unsigned*)((const char*)(gbase) + (voff)[_i]), (PG8_LAS unsigned*)(lds + (bufoff) + ldsw + _i * 8192), 16, 0, 0); } while (0)
#define PG8_LDA(dst, b, h) do { _Pragma("unroll") for (int m = 0; m < 4; ++m) { if constexpr (F8) { dst##8[m] = *(const PG8_LAS v8ia_*)(lds + PG8_SA(b, h) + aoff + m * 2048); } else { _Pragma("unroll") for (int k = 0; k < 2; ++k) dst[m][k] = *(const PG8_LAS bf16x8*)(lds + PG8_SA(b, h) + aoff + m * 2048 + k * 1024); } } } while (0)
#define PG8_LDB(dst, b, h) do { _Pragma("unroll") for (int n = 0; n < 2; ++n) { if constexpr (F8) { dst##8[n] = *(const PG8_LAS v8ia_*)(lds + PG8_SB(b, h) + boff + n * 2048); } else { _Pragma("unroll") for (int k = 0; k < 2; ++k) dst[n][k] = *(const PG8_LAS bf16x8*)(lds + PG8_SB(b, h) + boff + n * 2048 + k * 1024); } } } while (0)
#define PG8_MMA(ai, bj, At, Bt) do { __builtin_amdgcn_s_setprio(1); _Pragma("unroll") for (int m = 0; m < 4; ++m) _Pragma("unroll") for (int n = 0; n < 2; ++n) { \
        if constexpr (F8) asm volatile("v_mfma_scale_f32_16x16x128_f8f6f4 %0, %1, %2, %0, %3, %3 op_sel_hi:[0,0,0]" : "+v"(acc[ai][bj][m][n]) : "v"(Bt##8[n]), "v"(At##8[m]), "v"(sc1_));   \
        else { _Pragma("unroll") for (int k = 0; k < 2; ++k) acc[ai][bj][m][n] = __builtin_amdgcn_mfma_f32_16x16x32_bf16(Bt[n][k], At[m][k], acc[ai][bj][m][n], 0, 0, 0); } } \
        __builtin_amdgcn_s_setprio(0); } while (0)
#define PG8_WAIT_V(n) asm volatile("s_waitcnt vmcnt(" #n ")" ::: "memory")
#define PG8_WAIT_L(n) asm volatile("s_waitcnt lgkmcnt(" #n ")" ::: "memory")
#define PG8_BAR asm volatile("s_barrier" ::: "memory")
#define PG8_SCHED __builtin_amdgcn_sched_barrier(0)
    Unit cur, nxt; int ui = 0;
    if (!S.next(0, cur)) return;
    f32x4 acc[2][2][4][2];
#pragma unroll
    for (int a = 0; a < 2; ++a)
#pragma unroll
        for (int b = 0; b < 2; ++b)
#pragma unroll
            for (int m = 0; m < 4; ++m)
#pragma unroll
                for (int n = 0; n < 2; ++n) { acc[a][b][m][n] = (f32x4){0.f, 0.f, 0.f, 0.f}; if constexpr (F8) asm volatile("" : "+v"(acc[a][b][m][n])); }
    typedef int v8i_ __attribute__((ext_vector_type(8))); typedef int v8ia_ __attribute__((ext_vector_type(8), aligned(16)));
    const int sc1_ = 0x7f7f7f7f;
    bf16x8 At[4][2], B0[2][2], B1[2][2]; v8i_ At8[4], B08[2], B18[2];
    const char* cA = (const char*)g.A + (size_t)cur.pm * tstep; const char* cB = (const char*)g.Bt + (size_t)cur.pn * tstep;
    S.a_ready(cur);
    if constexpr (SP2) {
        PG8_STAGE(PG8_SB(0, 0), cB, voffB); PG8_STAGE(PG8_SB(0, 1), cB + hstep, voffB); PG8_STAGE(PG8_SA(0, 0), cA, voffA); PG8_STAGE(PG8_SA(0, 1), cA + hstep, voffA);
        if (wr == 1) PG8_BAR;
        PG8_WAIT_V(2); PG8_BAR;
        PG8_STAGE(PG8_SB(1, 0), cB + kstep, voffB); PG8_STAGE(PG8_SA(1, 0), cA + kstep, voffA); PG8_STAGE(PG8_SB(1, 1), cB + hstep + kstep, voffB);
        PG8_WAIT_V(6); PG8_BAR;
    } else {
        PG8_STAGE(PG8_SB(0, 0), cB, voffB); PG8_STAGE(PG8_SA(0, 0), cA, voffA); PG8_STAGE(PG8_SB(0, 1), cB + hstep, voffB); PG8_STAGE(PG8_SA(0, 1), cA + hstep, voffA);
        if (wr == 1) PG8_BAR;
        PG8_WAIT_V(4); PG8_BAR;
        PG8_STAGE(PG8_SB(1, 0), cB + kstep, voffB); PG8_STAGE(PG8_SA(1, 0), cA + kstep, voffA); PG8_STAGE(PG8_SB(1, 1), cB + hstep + kstep, voffB);
        PG8_WAIT_V(6); PG8_BAR;
    }
    for (;;) {
        const bool has_next = S.next(ui + 1, nxt);
        const char* nA = has_next ? (const char*)g.A + (size_t)nxt.pm * tstep : cA; const char* nB = has_next ? (const char*)g.Bt + (size_t)nxt.pn * tstep : cB;
        for (int hh = 0; hh < (Epi::MID ? 2 : 1); ++hh) {
        if (Epi::MID && hh == 1) {
            if (ALIGN_EPI && wr == 0) PG8_BAR;
            E.mid(acc, cur, wr, wc, fr, fq); __builtin_amdgcn_sched_barrier(0);
            if (ALIGN_EPI && wr == 1) PG8_BAR; }
        const int t_lo = Epi::MID ? hh * (nt >> 1) : 0, t_hi = Epi::MID ? (hh + 1) * (nt >> 1) : nt;
        for (int t = t_lo; t < t_hi; t += 2) {
            const bool last = (t == nt - 2);
            const char* a1 = cA + (size_t)(t + 1) * kstep;
            const char* a2 = last ? nA : cA + (size_t)(t + 2) * kstep; const char* b2 = last ? nB : cB + (size_t)(t + 2) * kstep;
            const char* a3 = a2 + kstep; const char* b3 = b2 + kstep;
            if (last && has_next) S.a_ready(nxt);
            if constexpr (SP2) {
            PG8_LDB(B0, 0, 0); PG8_LDB(B1, 0, 1); PG8_SCHED; PG8_LDA(At, 0, 0); PG8_STAGE(PG8_SA(1, 1), a1 + hstep, voffA);
            PG8_WAIT_V(8); PG8_WAIT_L(0); PG8_BAR; PG8_MMA(0, 0, At, B0); PG8_MMA(0, 1, At, B1); PG8_BAR; PG8_SCHED;
            PG8_LDA(At, 0, 1); PG8_STAGE(PG8_SB(0, 0), b2, voffB); PG8_STAGE(PG8_SB(0, 1), b2 + hstep, voffB); PG8_STAGE(PG8_SA(0, 0), a2, voffA);
            PG8_WAIT_V(8); PG8_WAIT_L(0); PG8_BAR; PG8_MMA(1, 0, At, B0); PG8_MMA(1, 1, At, B1); PG8_BAR; PG8_SCHED;
            PG8_LDB(B0, 1, 0); PG8_LDB(B1, 1, 1); PG8_SCHED; PG8_LDA(At, 1, 0); PG8_STAGE(PG8_SA(0, 1), a2 + hstep, voffA);
            PG8_WAIT_V(8); PG8_WAIT_L(0); PG8_BAR; PG8_MMA(0, 0, At, B0); PG8_MMA(0, 1, At, B1); PG8_BAR; PG8_SCHED;
            PG8_LDA(At, 1, 1); PG8_STAGE(PG8_SB(1, 0), b3, voffB); PG8_STAGE(PG8_SB(1, 1), b3 + hstep, voffB); PG8_STAGE(PG8_SA(1, 0), a3, voffA);
            PG8_WAIT_V(8); PG8_WAIT_L(0); PG8_BAR; PG8_MMA(1, 0, At, B0); PG8_MMA(1, 1, At, B1); PG8_BAR; PG8_SCHED;
            } else {
            PG8_LDB(B0, 0, 0); PG8_SCHED; PG8_LDA(At, 0, 0); PG8_STAGE(PG8_SA(1, 1), a1 + hstep, voffA);
            PG8_WAIT_L(8); PG8_BAR; PG8_WAIT_L(0); PG8_MMA(0, 0, At, B0); PG8_BAR; PG8_SCHED;
            PG8_LDB(B1, 0, 1); PG8_STAGE(PG8_SB(0, 0), b2, voffB);
            PG8_BAR; PG8_WAIT_L(0); PG8_MMA(0, 1, At, B1); PG8_BAR;
            PG8_LDA(At, 0, 1); PG8_STAGE(PG8_SA(0, 0), a2, voffA);
            PG8_BAR; PG8_WAIT_L(0); PG8_MMA(1, 0, At, B0); PG8_BAR; PG8_SCHED;
            PG8_STAGE(PG8_SB(0, 1), b2 + hstep, voffB);
            PG8_WAIT_V(6); PG8_BAR; PG8_MMA(1, 1, At, B1); PG8_BAR;
            PG8_LDB(B0, 1, 0); PG8_SCHED; PG8_LDA(At, 1, 0); PG8_STAGE(PG8_SA(0, 1), a2 + hstep, voffA);
            PG8_WAIT_L(8); PG8_BAR; PG8_WAIT_L(0); PG8_MMA(0, 0, At, B0); PG8_BAR; PG8_SCHED;
            PG8_LDB(B1, 1, 1); PG8_STAGE(PG8_SB(1, 0), b3, voffB);
            PG8_BAR; PG8_WAIT_L(0); PG8_MMA(0, 1, At, B1); PG8_BAR;
            PG8_LDA(At, 1, 1); PG8_STAGE(PG8_SA(1, 0), a3, voffA);
            PG8_BAR; PG8_WAIT_L(0); PG8_MMA(1, 0, At, B0); PG8_BAR; PG8_SCHED;
            PG8_STAGE(PG8_SB(1, 1), b3 + hstep, voffB);
            PG8_WAIT_V(6); PG8_BAR; PG8_MMA(1, 1, At, B1); PG8_BAR;
            }
        }
        }
        if constexpr (ALIGN_EPI) { if (wr == 0) PG8_BAR; }
        if constexpr (F8) asm volatile("s_nop 15\n\ts_nop 15" ::: "memory");
        if constexpr (!Epi::AFTER_DRAIN) { E(acc, cur, wr, wc, fr, fq); S.done(cur); }
        if (!has_next) break;
#pragma unroll
        for (int a = 0; a < 2; ++a)
#pragma unroll
            for (int b = 0; b < 2; ++b)
#pragma unroll
                for (int m = 0; m < 4; ++m)
#pragma unroll
                    for (int n = 0; n < 2; ++n) { acc[a][b][m][n] = (f32x4){0.f, 0.f, 0.f, 0.f}; if constexpr (F8) asm volatile("" : "+v"(acc[a][b][m][n])); }
        cur = nxt; cA = nA; cB = nB; ++ui;
        if constexpr (ALIGN_EPI) { if (wr == 1) PG8_BAR; }
    }
    PG8_WAIT_V(0);
    if constexpr (!ALIGN_EPI) { if (wr == 0) PG8_BAR; }
    PG8_BAR;
    if constexpr (Epi::AFTER_DRAIN) { E.fused(acc, cur, wr, wc, fr, fq, lds, wid, lane); S.done(cur); }
#undef PG8_SA
#undef PG8_SB
#undef PG8_STAGE
#undef PG8_LDA
#undef PG8_LDB
#undef PG8_MMA
#undef PG8_WAIT_V
#undef PG8_WAIT_L
#undef PG8_BAR
#undef PG8_SCHED
}

}
namespace att {
#define ALAS __attribute__((address_space(3)))
typedef short bf16x8 __attribute__((ext_vector_type(8)));
typedef float f32x16 __attribute__((ext_vector_type(16)));
typedef float f32x4 __attribute__((ext_vector_type(4)));
typedef unsigned u32x4 __attribute__((ext_vector_type(4)));
typedef unsigned u32x2 __attribute__((ext_vector_type(2)));
typedef unsigned short bf16_t;
typedef int v8i_ __attribute__((ext_vector_type(8))); typedef int v8ia_ __attribute__((ext_vector_type(8), aligned(16)));
constexpr int ROW8 = 80;
constexpr int ROWB = 144, TILEB = 64 * ROWB;
constexpr int L_K = 0, L_V = 4 * TILEB, L_C = 8 * TILEB, L_KM = L_C + 1024, L_SEL = L_KM + 4096, L_END = L_SEL + 1024;
constexpr float NEG = -1e30f;
constexpr float THR = 44.0f;
struct Tens { const bf16_t *QA, *KA, *VTA, *QB, *KB, *VTB; bf16_t* O; const float *KMP, *CL; };
__device__ __forceinline__ unsigned pk(float lo, float hi) { return pg8::cvt_pk_bf16(lo, hi); }
__device__ __forceinline__ float blo(unsigned w) { return __uint_as_float(w << 16); }
__device__ __forceinline__ float bhi(unsigned w) { return __uint_as_float(w & 0xffff0000u); }
#define AMFMA(a, b, c) __builtin_amdgcn_mfma_f32_32x32x16_bf16(a, b, c, 0, 0, 0)

template <bool FOX> __device__ __forceinline__ void unit(ALAS unsigned char* lds, const Tens& T, int bh, int qb, float qk2max, float qk2max_a) {
    int tid_ = threadIdx.x; asm volatile("" : "+v"(tid_));
    const int tid = tid_, lane = tid & 63, r32 = lane & 31, hi = lane >> 5;
    const int w = __builtin_amdgcn_readfirstlane(tid >> 6);
    const int b = bh >> 3, h = bh & 7;
    const size_t rowbase = (size_t)b * SEQ; const int q0 = qb * 256;
    const bf16_t* Q = FOX ? T.QB : T.QA; const bf16_t* K = FOX ? T.KB : T.KA; const bf16_t* VT = (FOX ? T.VTB : T.VTA) + (size_t)bh * 64 * SEQ;
    const float* CLs = T.CL + (size_t)bh * SEQ;
    bf16x8 qr[4];
    { const bf16_t* qp = Q + (rowbase + q0 + 32 * w + r32) * 512 + h * 64 + 8 * hi;
#pragma unroll
      for (int d0 = 0; d0 < 4; ++d0) qr[d0] = *(const bf16x8*)(qp + 16 * d0); }
    unsigned selq = 0u; float cq = 0.f, cqw = 0.f, cq0 = 0.f;
    v8i_ q8 = {};
    if constexpr (!FOX) { const u32x4* qp8 = (const u32x4*)(Q + (rowbase + q0 + 32 * w + r32) * 512 + h * 64 + 32 * hi);
#pragma unroll
        for (int j = 0; j < 4; ++j) { const u32x4 v = qp8[j];
            int a = __builtin_amdgcn_cvt_pk_fp8_f32(blo(v.x), bhi(v.x), 0, false); a = __builtin_amdgcn_cvt_pk_fp8_f32(blo(v.y), bhi(v.y), a, true);
            int c = __builtin_amdgcn_cvt_pk_fp8_f32(blo(v.z), bhi(v.z), 0, false); c = __builtin_amdgcn_cvt_pk_fp8_f32(blo(v.w), bhi(v.w), c, true);
            q8[2 * j] = a; q8[2 * j + 1] = c; } }
    if constexpr (!FOX) {
        ALAS float* KM = (ALAS float*)(lds + L_KM); ALAS unsigned* SEL = (ALAS unsigned*)(lds + L_SEL);
        { const int qi = tid >> 1, half = tid & 1;
          const u32x4* qp = (const u32x4*)(Q + (rowbase + q0 + qi) * 512 + h * 64 + 32 * half);
          float qf[32];
#pragma unroll
          for (int j = 0; j < 4; ++j) { const u32x4 v = qp[j]; qf[8 * j + 0] = blo(v.x); qf[8 * j + 1] = bhi(v.x); qf[8 * j + 2] = blo(v.y); qf[8 * j + 3] = bhi(v.y); qf[8 * j + 4] = blo(v.z); qf[8 * j + 5] = bhi(v.z); qf[8 * j + 6] = blo(v.w); qf[8 * j + 7] = bhi(v.w); }
          float v1 = -INFINITY, v2 = -INFINITY, v3 = -INFINITY; int i1 = 0, i2 = 0, i3 = 0;
          for (int n = 0; n < qb; ++n) {
              const ALAS f32x4* kp = (const ALAS f32x4*)(KM + n * 64 + 32 * half); float g = 0.f;
#pragma unroll
              for (int j = 0; j < 8; ++j) { const f32x4 kk = kp[j]; g += (qf[4 * j] * kk[0] + qf[4 * j + 1] * kk[1]) + (qf[4 * j + 2] * kk[2] + qf[4 * j + 3] * kk[3]); }
              g += __shfl_xor(g, 1);
              if (g > v1) { v3 = v2; i3 = i2; v2 = v1; i2 = i1; v1 = g; i1 = n; } else if (g > v2) { v3 = v2; i3 = i2; v2 = g; i2 = n; } else if (g > v3) { v3 = g; i3 = n; }
          }
          const unsigned mask = (qb <= 3) ? ((1u << qb) - 1u) : ((1u << i1) | (1u << i2) | (1u << i3));
          if (half == 0) SEL[qi] = mask; }
        __syncthreads();
        selq = SEL[32 * w + r32];
    } else { cq = CLs[q0 + 32 * w + r32]; cqw = CLs[q0 + 32 * w]; cq0 = CLs[q0]; }
    const int NTmax = 4 + 4 * qb;
#define KV0(i) (FOX ? (q0 + 192 - 64 * (i)) : ((i) < 4 ? q0 + 64 * (i) : 64 * ((i) - 4)))
    const bf16_t* kg = K + (rowbase + (tid >> 3)) * 512 + h * 64 + (tid & 7) * 8;
    const bf16_t* vg = VT + (size_t)(tid >> 3) * SEQ + (tid & 7) * 8;
    const unsigned stoff = FOX ? (unsigned)((tid >> 3) * ROWB + (tid & 7) * 16) : (unsigned)((tid >> 3) * ROW8 + (tid & 7) * 8);
    const unsigned stoffv = (unsigned)((tid >> 3) * ROWB + (tid & 7) * 16);
    u32x4 kA0, vA0, kA1, vA1; f32x4 cA0 = (f32x4){0.f, 0.f, 0.f, 0.f}, cA1 = cA0;
#define LOADT(KR, VR, CR, kv) do { KR = *(const u32x4*)(kg + (size_t)(kv) * 512); VR = *(const u32x4*)(vg + (kv)); if (FOX && tid < 16) CR = *(const f32x4*)(CLs + (kv) + 4 * tid); } while (0)
#define CVT8(R) (u32x2){(unsigned)__builtin_amdgcn_cvt_pk_fp8_f32(blo(R.y), bhi(R.y), __builtin_amdgcn_cvt_pk_fp8_f32(blo(R.x), bhi(R.x), 0, false), true), (unsigned)__builtin_amdgcn_cvt_pk_fp8_f32(blo(R.w), bhi(R.w), __builtin_amdgcn_cvt_pk_fp8_f32(blo(R.z), bhi(R.z), 0, false), true)}
#define STORET(KR, VR, CR, sl) do { if (FOX) { *(ALAS u32x4*)(lds + L_K + (sl) * TILEB + stoff) = KR; *(ALAS u32x4*)(lds + L_V + (sl) * TILEB + stoff) = VR; if (tid < 16) *(ALAS f32x4*)(lds + L_C + (sl) * 256 + 16 * tid) = CR; } \
        else { *(ALAS u32x2*)(lds + L_K + (sl) * TILEB + stoff) = CVT8(KR); *(ALAS u32x4*)(lds + L_V + (sl) * TILEB + stoffv) = VR; } } while (0)
    int NT = NTmax;
    if (FOX) {
        const int kk = q0 - 1 - 64 * lane; const float cv = CLs[kk < 0 ? 0 : kk];
        const unsigned long long ok = __builtin_amdgcn_ballot_w64((kk >= 0) && ((2.f * qk2max + cq0 - cv) >= -THR));
        const int npast = (~ok == 0ull) ? 64 : __builtin_ctzll(~ok);
        NT = 4 + (npast < 4 * qb ? npast : 4 * qb);
    }
    const int NS = (NT + 1) >> 1;
    const float qkref = FOX ? qk2max : qk2max_a; const float cqb = cq - qkref;
    float l = 0.f; f32x16 o0 = {}, o1 = {}; const int sc1a = 0x7f7f7f7f;
#define SKIPT(i, sl, OUT) do { const bool diag_ = (i) < 4; const int j_ = FOX ? 3 - (i) : (i); OUT = diag_ && (j_ > (w >> 1)); \
        if (FOX) { const float ckl = *(const ALAS float*)(lds + L_C + (sl) * 256 + 252); if ((2.f * qk2max + cqw - ckl) < -THR) OUT = true; } } while (0)
#define S_PART(P0, P1, i, sl, kv0) do { \
        if (FOX) { const ALAS unsigned char* cbp = lds + L_C + (sl) * 256 + hi * 16; \
            _Pragma("unroll") for (int g = 0; g < 4; ++g) { const f32x4 c0 = *(const ALAS f32x4*)(cbp + g * 32), c1 = *(const ALAS f32x4*)(cbp + 128 + g * 32); \
                _Pragma("unroll") for (int e = 0; e < 4; ++e) { P0[4 * g + e] = cqb - c0[e]; P1[4 * g + e] = cqb - c1[e]; } } } \
        else { const float cb = (((i) < 4) || ((selq >> ((kv0) >> 8)) & 1u)) ? -qkref : NEG; \
            _Pragma("unroll") for (int r = 0; r < 16; ++r) { P0[r] = cb; P1[r] = cb; } } \
        if (FOX) { const ALAS unsigned char* kb = lds + L_K + (sl) * TILEB + r32 * ROWB + hi * 16; \
            _Pragma("unroll") for (int d0 = 0; d0 < 4; ++d0) { const bf16x8 a0 = *(const ALAS bf16x8*)(kb + d0 * 32), a1 = *(const ALAS bf16x8*)(kb + 32 * ROWB + d0 * 32); P0 = AMFMA(a0, qr[d0], P0); P1 = AMFMA(a1, qr[d0], P1); } } \
        else { const ALAS unsigned char* kb = lds + L_K + (sl) * TILEB + r32 * ROW8 + hi * 32; \
            const v8i_ a0 = *(const ALAS v8ia_*)kb, a1 = *(const ALAS v8ia_*)(kb + 32 * ROW8); \
            P0 = __builtin_amdgcn_mfma_scale_f32_32x32x64_f8f6f4(a0, q8, P0, 0, 0, 0, 0x7f7f7f7f, 0, 0x7f7f7f7f); P1 = __builtin_amdgcn_mfma_scale_f32_32x32x64_f8f6f4(a1, q8, P1, 0, 0, 0, 0x7f7f7f7f, 0, 0x7f7f7f7f); } } while (0)
#define M_PART(P0, P1, i) do { if ((i) < 4) { const int j_ = FOX ? 3 - (i) : (i); const int qrel = 32 * w + r32, kb0 = 64 * j_ + 4 * hi; \
            _Pragma("unroll") for (int r = 0; r < 16; ++r) { const int kvr = kb0 + (r & 3) + 8 * (r >> 2); if (kvr > qrel) P0[r] = NEG; if (kvr + 32 > qrel) P1[r] = NEG; } } } while (0)
#define E_PART(P0, P1) do { float sum = 0.f; \
        _Pragma("unroll") for (int r = 0; r < 16; ++r) { P0[r] = __builtin_amdgcn_exp2f(P0[r]); P1[r] = __builtin_amdgcn_exp2f(P1[r]); sum += P0[r] + P1[r]; } \
        l += sum; } while (0)
#define PV_PART(P0, P1, sl) do { if (true) { const ALAS unsigned char* vbp = lds + L_V + (sl) * TILEB + r32 * ROWB + hi * 16; \
        _Pragma("unroll") for (int s_ = 0; s_ < 4; ++s_) { const int rb = 8 * (s_ & 1); u32x4 pw; \
            if (s_ < 2) { pw.x = pk(P0[rb], P0[rb + 1]); pw.y = pk(P0[rb + 2], P0[rb + 3]); pw.z = pk(P0[rb + 4], P0[rb + 5]); pw.w = pk(P0[rb + 6], P0[rb + 7]); } \
            else        { pw.x = pk(P1[rb], P1[rb + 1]); pw.y = pk(P1[rb + 2], P1[rb + 3]); pw.z = pk(P1[rb + 4], P1[rb + 5]); pw.w = pk(P1[rb + 6], P1[rb + 7]); } \
            const bf16x8 pb = __builtin_bit_cast(bf16x8, pw); \
            const bf16x8 a0 = *(const ALAS bf16x8*)(vbp + s_ * 32), a1 = *(const ALAS bf16x8*)(vbp + 32 * ROWB + s_ * 32); \
            o0 = AMFMA(a0, pb, o0); o1 = AMFMA(a1, pb, o1); } } \
        else { v8i_ pw8; \
            _Pragma("unroll") for (int j_ = 0; j_ < 4; ++j_) { int a_ = __builtin_amdgcn_cvt_pk_fp8_f32(P0[4 * j_], P0[4 * j_ + 1], 0, false); a_ = __builtin_amdgcn_cvt_pk_fp8_f32(P0[4 * j_ + 2], P0[4 * j_ + 3], a_, true); pw8[j_] = a_; \
                int c_ = __builtin_amdgcn_cvt_pk_fp8_f32(P1[4 * j_], P1[4 * j_ + 1], 0, false); c_ = __builtin_amdgcn_cvt_pk_fp8_f32(P1[4 * j_ + 2], P1[4 * j_ + 3], c_, true); pw8[4 + j_] = c_; } \
            const ALAS unsigned char* vb8 = lds + L_V + (sl) * TILEB + r32 * ROW8 + hi * 32; \
            const v8i_ a0 = *(const ALAS v8ia_*)vb8, a1 = *(const ALAS v8ia_*)(vb8 + 32 * ROW8); \
            o0 = __builtin_amdgcn_mfma_scale_f32_32x32x64_f8f6f4(a0, pw8, o0, 0, 0, 0, 0x7f7f7f7f, 0, 0x7f7f7f7f); o1 = __builtin_amdgcn_mfma_scale_f32_32x32x64_f8f6f4(a1, pw8, o1, 0, 0, 0, 0x7f7f7f7f, 0, 0x7f7f7f7f); } } while (0)
#define COMPUTE2(i, sl) do { bool ska, skb; SKIPT((i), (sl), ska); SKIPT((i) + 1, (sl) + 1, skb); \
        if (!ska && !skb) { f32x16 pa0, pa1, pb0, pb1; \
            S_PART(pa0, pa1, (i), (sl), KV0(i)); S_PART(pb0, pb1, (i) + 1, (sl) + 1, KV0((i) + 1)); \
            M_PART(pa0, pa1, (i)); M_PART(pb0, pb1, (i) + 1); E_PART(pa0, pa1); E_PART(pb0, pb1); \
            PV_PART(pa0, pa1, (sl)); PV_PART(pb0, pb1, (sl) + 1); } \
        else { if (!ska) { f32x16 pa0, pa1; S_PART(pa0, pa1, (i), (sl), KV0(i)); M_PART(pa0, pa1, (i)); E_PART(pa0, pa1); PV_PART(pa0, pa1, (sl)); } \
               if (!skb) { f32x16 pb0, pb1; S_PART(pb0, pb1, (i) + 1, (sl) + 1, KV0((i) + 1)); M_PART(pb0, pb1, (i) + 1); E_PART(pb0, pb1); PV_PART(pb0, pb1, (sl) + 1); } } } while (0)
    {
        LOADT(kA0, vA0, cA0, KV0(0)); LOADT(kA1, vA1, cA1, KV0(1));
        for (int S = 0;; ++S) {
            const int sl = (S & 1) * 2;
            STORET(kA0, vA0, cA0, sl); STORET(kA1, vA1, cA1, sl + 1); __syncthreads();
            const bool more = (S + 1) < NS; if (more) { LOADT(kA0, vA0, cA0, KV0(2 * S + 2)); LOADT(kA1, vA1, cA1, KV0(2 * S + 3)); }
            COMPUTE2(2 * S, sl);
            if (!more) break;
        }
    }
    __syncthreads();
#undef COMPUTE2
#undef SKIPT
#undef S_PART
#undef M_PART
#undef E_PART
#undef PV_PART
    l += __shfl_xor(l, 32);
    const float inv = 1.0f / l;
    bf16_t* op = T.O + (rowbase + q0 + 32 * w + r32) * 1024 + (FOX ? 512 : 0) + h * 64 + 4 * hi;
#pragma unroll
    for (int g = 0; g < 4; ++g) { u32x2 v; v.x = pk(o0[4 * g] * inv, o0[4 * g + 1] * inv); v.y = pk(o0[4 * g + 2] * inv, o0[4 * g + 3] * inv); *(u32x2*)(op + 8 * g) = v;
        u32x2 z; z.x = pk(o1[4 * g] * inv, o1[4 * g + 1] * inv); z.y = pk(o1[4 * g + 2] * inv, o1[4 * g + 3] * inv); *(u32x2*)(op + 32 + 8 * g) = z; }
#undef KV0
#undef LOADT
#undef STORET
}
}

#define LAS __attribute__((address_space(3)))
typedef unsigned short bf16;
typedef unsigned v4u __attribute__((ext_vector_type(4)));
typedef unsigned v2u __attribute__((ext_vector_type(2)));
typedef float f32x4 __attribute__((ext_vector_type(4)));
constexpr size_t MiB = 1u << 20;
constexpr size_t WS_WIN = 1 * MiB, WS_WBR = 11 * MiB, WS_WOUT = 13 * MiB, WS_WUP = 15 * MiB, WS_WDN = 26 * MiB, WS_ROPE = 32 * MiB, WS_LOGF = 33 * MiB, WS_CL = 35 * MiB,
                 WS_KMP = 37 * MiB, WS_SSQ = 38 * MiB, WS_G01 = 42 * MiB, WS_U01 = 48 * MiB, WS_GT = 54 * MiB, WS_H = 64 * MiB, WS_QKV = 192 * MiB, WS_GATES = 576 * MiB, WS_O = 832 * MiB, WS_END = 960 * MiB;
constexpr size_t WS_MERGED = WS_H, WS_ACT = WS_QKV, WS_X1B = WS_GATES;
constexpr int RING_BYTES = 131072, XCH_OFF = RING_BYTES, LDS_BYTES = 147456;
constexpr int NWAVES = 8;
#define XSYNC() xcd_barrier(xbar)
#define GEMM_PHASE(EPI) pg8::gemm_phase<EPI, pg8::StaticOrder, true, true>(lds, g, S, E)
#define GSYNC() do { asm volatile("s_waitcnt vmcnt(0) lgkmcnt(0)" ::: "memory"); __syncthreads(); \
    if (threadIdx.x == 0) { __builtin_amdgcn_fence(__ATOMIC_RELEASE, "agent"); asm volatile("s_waitcnt vmcnt(0)" ::: "memory"); } __syncthreads(); \
    grid.sync(); \
    if (threadIdx.x == 0) { __builtin_amdgcn_fence(__ATOMIC_ACQUIRE, "agent"); asm volatile("s_waitcnt vmcnt(0)" ::: "memory"); } __syncthreads(); } while (0)

struct Params { const float* in[17]; float* out; unsigned char* ws; };

__device__ __forceinline__ float wave_sum(float v) {
#pragma unroll
    for (int o = 1; o < 64; o <<= 1) v += __shfl_xor(v, o);
    return v;
}
__device__ __forceinline__ unsigned f2bf(float f) { unsigned u = __builtin_bit_cast(unsigned, f); return (u + 0x7fffu + ((u >> 16) & 1u)) >> 16; }
__device__ __forceinline__ unsigned pk2(float lo, float hi) { return f2bf(lo) | (f2bf(hi) << 16); }

__device__ __forceinline__ void tr_item(const float* W, int ldn, int k0, int nsrc0, bf16* WT, int ldk, int ndst0, int kd0, const float* ksc, LAS float* scr, int lane) {
#pragma unroll 8
    for (int i = 0; i < 32; ++i) { const int kk = 2 * i + (lane >> 5); float v = W[(size_t)(k0 + kk) * ldn + nsrc0 + (lane & 31)]; if (ksc) v *= ksc[k0 + kk]; scr[kk * 33 + (lane & 31)] = v; }
    asm volatile("s_waitcnt lgkmcnt(0)" ::: "memory");
    const int c = lane & 7;
#pragma unroll
    for (int j = 0; j < 4; ++j) { const int n = (lane >> 3) + 8 * j; const LAS float* s = scr + (8 * c) * 33 + n;
        v4u o; o.x = pk2(s[0 * 33], s[1 * 33]); o.y = pk2(s[2 * 33], s[3 * 33]); o.z = pk2(s[4 * 33], s[5 * 33]); o.w = pk2(s[6 * 33], s[7 * 33]);
        *(v4u*)(WT + (size_t)(ndst0 + n) * ldk + kd0 + k0 + 8 * c) = o; }
    asm volatile("s_waitcnt lgkmcnt(0)" ::: "memory");
}
__device__ __forceinline__ void tr_item8(const float* W, int ldn, int k0, int nsrc0, unsigned char* WT8, int ldk, int ndst0, float scale, LAS float* scr, int lane) {
#pragma unroll 8
    for (int i = 0; i < 32; ++i) { const int kk = 2 * i + (lane >> 5); scr[kk * 33 + (lane & 31)] = W[(size_t)(k0 + kk) * ldn + nsrc0 + (lane & 31)] * scale; }
    asm volatile("s_waitcnt lgkmcnt(0)" ::: "memory");
    const int c = lane & 7;
#pragma unroll
    for (int j = 0; j < 4; ++j) { const int n = (lane >> 3) + 8 * j; const LAS float* sp = scr + (8 * c) * 33 + n;
        int w0 = __builtin_amdgcn_cvt_pk_fp8_f32(sp[0 * 33], sp[1 * 33], 0, false); w0 = __builtin_amdgcn_cvt_pk_fp8_f32(sp[2 * 33], sp[3 * 33], w0, true);
        int w1 = __builtin_amdgcn_cvt_pk_fp8_f32(sp[4 * 33], sp[5 * 33], 0, false); w1 = __builtin_amdgcn_cvt_pk_fp8_f32(sp[6 * 33], sp[7 * 33], w1, true);
        v2u o; o.x = (unsigned)w0; o.y = (unsigned)w1;
        *(v2u*)(WT8 + (size_t)(ndst0 + n) * ldk + k0 + 8 * c) = o; }
    asm volatile("s_waitcnt lgkmcnt(0)" ::: "memory");
}


#define XB_TMO      128
#define XB_XCNT(j)  (256  + 64 * (j))
#define XB_XSUB(j)  (1280 + 64 * (j))
#define XB_XGEN(j)  (2304 + 64 * (j))
#define XB_TOP      3328
#define XB_TOPGEN   3392
#define XCD_BAR_WORDS 3456
#define XB_SPIN_CAP (1u << 18)

__device__ __forceinline__ unsigned xb_ld(unsigned* p)              { return __hip_atomic_load(p, __ATOMIC_RELAXED, __HIP_MEMORY_SCOPE_AGENT); }
__device__ __forceinline__ unsigned xb_add(unsigned* p, unsigned v) { return __hip_atomic_fetch_add(p, v, __ATOMIC_RELAXED, __HIP_MEMORY_SCOPE_AGENT); }
__device__ __forceinline__ unsigned xb_xcc_id() { return (unsigned)__builtin_amdgcn_s_getreg((3 << 11) | 20) & 0xFu; }
#define XB_SPIN(cond, bar) do { unsigned _sp = 0; while (cond) { __builtin_amdgcn_s_sleep(1); \
    if ((++_sp & 255u) == 0u) { if (xb_ld(&(bar)[XB_TMO])) break; if (_sp > XB_SPIN_CAP) { atomicAdd(&(bar)[XB_TMO], 1u); break; } } } } while (0)

struct XcdBarrier {
    unsigned* bar; unsigned x;
    volatile LAS unsigned* st;
};

__device__ __forceinline__ XcdBarrier xcd_barrier_post(unsigned* bar, volatile LAS unsigned* st) {
    XcdBarrier b; b.bar = bar; b.x = xb_xcc_id(); b.st = st;
    if (threadIdx.x == 0) (void)xb_add(&bar[XB_XCNT(b.x)], 1u);
    return b;
}
__device__ __forceinline__ void xcd_barrier_complete(unsigned* bar, unsigned x, unsigned& nloc, unsigned& nx) {
    const unsigned G = gridDim.x * gridDim.y * gridDim.z;
    unsigned sum, cnt, mine, sp = 0u;
    for (;;) {
        sum = 0u; cnt = 0u; mine = 0u;
#pragma unroll
        for (unsigned j = 0; j < 16; ++j) { const unsigned c = xb_ld(&bar[XB_XCNT(j)]); sum += c; cnt += (c > 0u) ? 1u : 0u; mine = (j == x) ? c : mine; }
        if (sum == G) break;
        __builtin_amdgcn_s_sleep(1);
        if ((++sp & 255u) == 0u) { if (xb_ld(&bar[XB_TMO])) break; if (sp > XB_SPIN_CAP) { atomicAdd(&bar[XB_TMO], 1u); break; } }
    }
    nloc = mine > 0u ? mine : 1u; nx = cnt > 0u ? cnt : 1u;
}

__device__ __forceinline__ void xcd_barrier(const XcdBarrier& b) {
    asm volatile("s_waitcnt vmcnt(0)" ::: "memory");
    __syncthreads();
    if (threadIdx.x == 0) {
        unsigned* bar = b.bar;
        __builtin_amdgcn_s_waitcnt(0);
        unsigned nloc = b.st[0], nx = b.st[1];
        if (nloc == 0u) { xcd_barrier_complete(bar, b.x, nloc, nx); b.st[0] = nloc; b.st[1] = nx; }
        const unsigned old = xb_add(&bar[XB_XSUB(b.x)], 1u);
        const unsigned gen = old / nloc;
        if (old + 1u == (gen + 1u) * nloc) {
            __builtin_amdgcn_fence(__ATOMIC_RELEASE, "agent");
            asm volatile("s_waitcnt vmcnt(0)" ::: "memory");
            const unsigned og = xb_add(&bar[XB_TOP], 1u);
            const unsigned tg = og / nx;
            if (og + 1u == (tg + 1u) * nx) xb_add(&bar[XB_TOPGEN], 1u);
            else XB_SPIN(xb_ld(&bar[XB_TOPGEN]) == tg, bar);
            __builtin_amdgcn_fence(__ATOMIC_ACQUIRE, "agent");
            xb_add(&bar[XB_XGEN(b.x)], 1u);
            asm volatile("s_waitcnt vmcnt(0)" ::: "memory");
        } else {
            XB_SPIN(xb_ld(&bar[XB_XGEN(b.x)]) == gen, bar);
            __builtin_amdgcn_fence(__ATOMIC_ACQUIRE, "agent");
            asm volatile("s_waitcnt vmcnt(0)" ::: "memory");
        }
    }
    __syncthreads();
}

#define WT_IN ((bf16*)(P.ws + WS_WIN))
#define WT_BR ((bf16*)(P.ws + WS_WBR))
#define WT_OUT ((bf16*)(P.ws + WS_WOUT))
#define WT_UP ((bf16*)(P.ws + WS_WUP))
#define WT_DN ((bf16*)(P.ws + WS_WDN))
#define ROPE ((float*)(P.ws + WS_ROPE))
#define GAINS ((float*)(P.ws + WS_ROPE + 512 * 1024))
#define LOGF ((float*)(P.ws + WS_LOGF))
#define CL ((float*)(P.ws + WS_CL))
#define KMP ((float*)(P.ws + WS_KMP))
#define SSQ ((float*)(P.ws + WS_SSQ))
#define G01 ((float*)(P.ws + WS_G01))
#define U01 ((float*)(P.ws + WS_U01))
#define GT ((float*)(P.ws + WS_GT))
#define H ((bf16*)(P.ws + WS_H))
#define H8 ((unsigned char*)(P.ws + WS_O))
#define WT_IN8 ((unsigned char*)(P.ws + WS_WIN + 6 * MiB))
#define MERGED ((bf16*)(P.ws + WS_MERGED))
#define ACT ((bf16*)(P.ws + WS_ACT))
#define X1B ((bf16*)(P.ws + WS_X1B))
#define GATES ((bf16*)(P.ws + WS_GATES))
#define OB ((bf16*)(P.ws + WS_O))
#define QA ((bf16*)(P.ws + WS_QKV))
#define KA (QA + (size_t)TOK * 512)
#define VTA (QA + (size_t)TOK * 1024)
#define QB (QA + (size_t)TOK * 1536)
#define KB (QA + (size_t)TOK * 2048)
#define VTB (QA + (size_t)TOK * 2560)
__global__ void __launch_bounds__(512, 2) fwd(Params P) {
    extern __shared__ __attribute__((aligned(16))) unsigned char lds_raw[];
    cg::grid_group grid = cg::this_grid();
    LAS unsigned char* lds = (LAS unsigned char*)lds_raw;
    const int tid = threadIdx.x, lane = tid & 63, wave = __builtin_amdgcn_readfirstlane(tid >> 6);
    const int G = gridDim.x, bx = blockIdx.x, vcu = (G % 8 == 0) ? (bx % 8) * (G / 8) + bx / 8 : bx;
    const float* x = P.in[0];
    volatile LAS unsigned* xst = (volatile LAS unsigned*)(lds + XCH_OFF + 8192);
    if (tid < 4) xst[tid] = 0u;
    __syncthreads();
    const XcdBarrier xbar = xcd_barrier_post((unsigned*)P.ws, xst);


    {
        LAS float* scr = (LAS float*)(lds + wave * 16384);
        const int gw = vcu * NWAVES + wave, NGW = G * NWAVES;
        constexpr int I_IN = 16 * 160, I_BR = 8 * 32, I_OUT = 16 * 32, I_UP = 16 * 176, I_DN = 44 * 32, NITEMS = I_IN + 2 * I_BR + I_OUT + I_UP + I_DN;
        for (int it = gw; it < NITEMS; it += NGW) {
            int r = it;
            if (r < I_IN) { const int kb = r / 160, nb = r % 160, pn = nb >> 3, c32 = nb & 7;
                const int lg = pn < 12 ? (pn >> 1) * 512 + ((pn & 1) * 4 + (c32 & 3)) * 64 + 32 * (c32 >> 2) : 3080 + (c32 >> 2) * 1024 + (pn - 12) * 128 + 32 * (c32 & 3);
                const bool f8t = ((pn >= 2 && pn <= 5) || pn >= 12);
                if (!f8t) tr_item(P.in[2], NCOL_IN, 64 * kb, lg, WT_IN, 1024, 256 * (pn < 2 ? pn : pn - 4) + 32 * c32, 0, nullptr, scr, lane);
                else tr_item8(P.in[2], NCOL_IN, 64 * kb, lg, WT_IN8, 1024, 256 * (pn < 6 ? pn - 2 : pn - 8) + 32 * c32, 64.0f, scr, lane);
                continue; } r -= I_IN;
            if (r < I_BR) { tr_item(P.in[9], 1024, 64 * (r / 32), 32 * (r % 32), WT_BR, 1024, 32 * (r % 32), 0, nullptr, scr, lane); continue; } r -= I_BR;
            if (r < I_BR) { tr_item(P.in[10], 1024, 64 * (r / 32), 32 * (r % 32), WT_BR, 1024, 32 * (r % 32), 512, nullptr, scr, lane); continue; } r -= I_BR;
            if (r < I_OUT) { tr_item(P.in[11], 1024, 64 * (r / 32), 32 * (r % 32), WT_OUT, 1024, 32 * (r % 32), 0, nullptr, scr, lane); continue; } r -= I_OUT;
            if (r < I_UP) { const int kb = r / 176, nb = r % 176, pn = nb >> 3, c32 = nb & 7;
                const int lg = c32 < 4 ? 128 * pn + 32 * c32 : DFF + 128 * pn + 32 * (c32 - 4);
                tr_item(P.in[13], 2 * DFF, 64 * kb, lg, WT_UP, 1024, 32 * nb, 0, P.in[12], scr, lane); continue; } r -= I_UP;
            tr_item(P.in[16], 1024, 64 * (r / 32), 32 * (r % 32), WT_DN, DFF, 32 * (r % 32), 0, nullptr, scr, lane);
        }
        {
            const float invf[8] = {1.0f, 0.19392274474868576f, 0.03760603093086393f, 0.007292664737217109f, 0.001414213562373095f, 0.0002742481756762073f, 5.318295896944988e-05f, 1.031338537721246e-05f};
            for (int id = (vcu * 512 + tid); id < SEQ * 8; id += G * 512) { const int pos = id >> 3, i = id & 7;
                float fi = invf[0];
#pragma unroll
                for (int q = 1; q < 8; ++q) fi = (i == q) ? invf[q] : fi;
                const float ang = (float)pos * fi; const double rev = (double)ang * 0.15915494309189535; const float fr = (float)(rev - __builtin_rint(rev));
                ROPE[pos * 16 + i] = __builtin_amdgcn_cosf(fr); ROPE[pos * 16 + 8 + i] = __builtin_amdgcn_sinf(fr); }
        }
        if (bx == 0 && tid < 256) GAINS[tid] = P.in[5 + (tid >> 6)][tid & 63];
        __syncthreads();
        LAS float* WfT = (LAS float*)lds;
        for (int idx = tid; idx < 8192; idx += 512) { const int k = idx >> 3, j = idx & 7; WfT[j * 1024 + k] = P.in[2][(size_t)k * NCOL_IN + 3072 + j]; }
        __syncthreads();
        f32x4 gv[4];
#pragma unroll
        for (int j = 0; j < 4; ++j) gv[j] = ((const f32x4*)P.in[1])[lane + 64 * j];
        const float bfg = P.in[3][lane & 7];
        f32x4 nv[4];
        if (gw < TOK) { const f32x4* xr = (const f32x4*)(x + (size_t)gw * DM) + lane;
#pragma unroll
            for (int j = 0; j < 4; ++j) nv[j] = xr[64 * j]; }
        for (int row = gw; row < TOK; row += NGW) {
            f32x4 v[4]; float ss = 0.f;
#pragma unroll
            for (int j = 0; j < 4; ++j) v[j] = nv[j];
            if (row + NGW < TOK) { const f32x4* xr = (const f32x4*)(x + (size_t)(row + NGW) * DM) + lane;
#pragma unroll
                for (int j = 0; j < 4; ++j) nv[j] = xr[64 * j]; }
#pragma unroll
            for (int j = 0; j < 4; ++j) ss += (v[j][0] * v[j][0] + v[j][1] * v[j][1]) + (v[j][2] * v[j][2] + v[j][3] * v[j][3]);
            const float rn = 1.0f / sqrtf(wave_sum(ss) * (1.0f / DM) + NORM_EPS);
            v2u* o8 = (v2u*)(H + (size_t)row * DM) + lane;
#pragma unroll
            for (int j = 0; j < 4; ++j) { v[j] = v[j] * rn * gv[j]; v2u o; o.x = pk2(v[j][0], v[j][1]); o.y = pk2(v[j][2], v[j][3]); o8[64 * j] = o;
                int w8 = __builtin_amdgcn_cvt_pk_fp8_f32(v[j][0], v[j][1], 0, false); w8 = __builtin_amdgcn_cvt_pk_fp8_f32(v[j][2], v[j][3], w8, true);
                ((unsigned*)(H8 + (size_t)row * DM))[lane + 64 * j] = (unsigned)w8; }
            float mine = 0.f;
#pragma unroll
            for (int jj = 0; jj < 8; ++jj) { float a = 0.f;
#pragma unroll
                for (int j = 0; j < 4; ++j) { const f32x4 wv = *(const LAS f32x4*)(WfT + jj * 1024 + 4 * lane + 256 * j); a += (v[j][0] * wv[0] + v[j][1] * wv[1]) + (v[j][2] * wv[2] + v[j][3] * wv[3]); }
                a = wave_sum(a); if (lane == jj) mine = a; }
            if (lane < 8) { const float z = mine + bfg; const float ls = fminf(z, 0.f) - __logf(1.0f + __expf(-fabsf(z))); LOGF[((size_t)(row >> 12) * 8 + lane) * SEQ + (row & (SEQ - 1))] = ls; }
        }
    }
    if (P.ws == nullptr) GSYNC();
    XSYNC();


    for (int bh = bx; bh < 128; bh += G) {
        LAS float* wt = (LAS float*)lds;
        const float* lf = LOGF + (size_t)bh * SEQ + 8 * tid; const f32x4 a = *(const f32x4*)lf, c = *(const f32x4*)(lf + 4);
        float pf[8]; pf[0] = a[0]; pf[1] = pf[0] + a[1]; pf[2] = pf[1] + a[2]; pf[3] = pf[2] + a[3]; pf[4] = pf[3] + c[0]; pf[5] = pf[4] + c[1]; pf[6] = pf[5] + c[2]; pf[7] = pf[6] + c[3];
        float xs = pf[7];
#pragma unroll
        for (int o = 1; o < 64; o <<= 1) { const float y = __shfl_up(xs, o); if (lane >= o) xs += y; }
        if (lane == 63) wt[wave] = xs;
        __syncthreads();
        float off = xs - pf[7];
        for (int q = 0; q < wave; ++q) off += wt[q];
        float* cp = CL + (size_t)bh * SEQ + 8 * tid;
        *(f32x4*)cp = (f32x4){(off + pf[0]) * LOG2E, (off + pf[1]) * LOG2E, (off + pf[2]) * LOG2E, (off + pf[3]) * LOG2E};
        *(f32x4*)(cp + 4) = (f32x4){(off + pf[4]) * LOG2E, (off + pf[5]) * LOG2E, (off + pf[6]) * LOG2E, (off + pf[7]) * LOG2E};
        __syncthreads();
    }
    {
        {
            pg8::Gemm g{H, WT_IN, TOK, 2048, 1024}; pg8::StaticOrder S; S.init(TOK, 2048, G, bx);
            pg8::EpiG1 E{QA, GATES, KMP, 0, 1.0f, GAINS, P.in[4], ROPE};
            GEMM_PHASE(pg8::EpiG1);
        }
        {
            pg8::Gemm g{(const pg8::bf16_t*)H8, (const pg8::bf16_t*)WT_IN8, TOK, 3072, 1024}; pg8::StaticOrder S; S.init(TOK, 3072, G, bx);
            pg8::EpiG1 E{QA, GATES, KMP, 4, 1.0f / 64.0f, GAINS, P.in[4], ROPE};
            pg8::gemm_phase<pg8::EpiG1, pg8::StaticOrder, true, true, true>(lds, g, S, E);
        }
    }
    XSYNC();


    {
        float mq = fabsf(P.in[7][lane]), mk = fabsf(P.in[8][lane]);
#pragma unroll
        for (int o = 1; o < 64; o <<= 1) { mq = fmaxf(mq, __shfl_xor(mq, o)); mk = fmaxf(mk, __shfl_xor(mk, o)); }
        const float qk2max = 64.0f * QSCALE * mq * mk * 1.02f;
        float mqa = fabsf(P.in[5][lane]), mka = fabsf(P.in[6][lane]);
#pragma unroll
        for (int o = 1; o < 64; o <<= 1) { mqa = fmaxf(mqa, __shfl_xor(mqa, o)); mka = fmaxf(mka, __shfl_xor(mka, o)); }
        const float qk2max_a = 64.0f * QSCALE * mqa * mka * 1.02f;
        const att::Tens T{QA, KA, VTA, QB, KB, VTB, OB, KMP, CL};
        if (wave >= 4) __builtin_amdgcn_s_setprio(1);
        for (int v = vcu; v < 256; v += G) {
            const int bh = v >> 1, par = v & 1;
            {
                LAS float* KMl = (LAS float*)(lds + att::L_KM);
                for (int idx = tid; idx < 1024; idx += 512) { const int n = idx >> 6, d = idx & 63; const float* kp = KMP + ((size_t)(bh * 16 + n) * 2) * 64 + d; KMl[idx] = (kp[0] + kp[64]) * (1.0f / 256.0f); }
                __syncthreads();
            }
            for (int i = 0; i < 8; ++i) { const int s = 4 * par + (i & 3); att::unit<false>(lds, T, bh, i < 4 ? 15 - s : s, qk2max, qk2max_a); }
            for (int i = 0; i < 8; ++i) att::unit<true>(lds, T, bh, 8 * par + i, qk2max, qk2max_a);
        }
        __builtin_amdgcn_s_setprio(0);
    }
    XSYNC();

    {
        pg8::Gemm g{OB, WT_BR, TOK, 1024, 1024}; pg8::StaticOrder S; S.init(TOK, 1024, G, bx);
        pg8::EpiG2 E{GATES, MERGED};
        GEMM_PHASE(pg8::EpiG2);
    }
    XSYNC();
    {
        pg8::Gemm g{MERGED, WT_OUT, TOK, 1024, 1024}; pg8::StaticOrder S; S.init(TOK, 1024, G, bx);
        pg8::EpiG3 E{x, P.out, X1B, SSQ};
        GEMM_PHASE(pg8::EpiG3);
    }
    XSYNC();
    {
        pg8::Gemm g{X1B, WT_UP, TOK, 2 * DFF, 1024}; pg8::StaticOrder S; S.init(TOK, 2 * DFF, G, bx);
        pg8::EpiG4 E{SSQ, P.in[14], P.in[15], ACT, G01, U01, GT, (LAS float*)(lds + XCH_OFF)};
        GEMM_PHASE(pg8::EpiG4);
    }
    XSYNC();
    {
        const float* cw = P.in[14]; const float* cb = P.in[15];
        for (int idx = bx * 512 + tid; idx < 256 * 2 * (DFF / 4); idx += G * 512) {
            const int f = 4 * (idx % (DFF / 4)), j = (idx / (DFF / 4)) & 1, pm = idx / (2 * (DFF / 4));
            if ((pm & 15) == 0) continue;
            const f32x4 g0 = *(const f32x4*)(G01 + ((size_t)pm * 2 + 0) * DFF + f), g1 = *(const f32x4*)(G01 + ((size_t)pm * 2 + 1) * DFF + f);
            const f32x4 gm2 = *(const f32x4*)(GT + ((size_t)(pm - 1) * 2 + 0) * DFF + f), gm1 = *(const f32x4*)(GT + ((size_t)(pm - 1) * 2 + 1) * DFF + f);
            const f32x4 uu = *(const f32x4*)(U01 + ((size_t)pm * 2 + j) * DFF + f);
            const f32x4 w0 = *(const f32x4*)(cw + f), w1 = *(const f32x4*)(cw + DFF + f), w2 = *(const f32x4*)(cw + 2 * DFF + f), bb = *(const f32x4*)(cb + f);
            const f32x4 cv = (j == 0) ? (w0 * gm2 + w1 * gm1 + w2 * g0 + bb) : (w0 * gm1 + w1 * g0 + w2 * g1 + bb);
            f32x4 a;
#pragma unroll
            for (int e = 0; e < 4; ++e) a[e] = cv[e] * pg8::sigm(cv[e]) * uu[e];
            v2u o; o.x = pk2(a[0], a[1]); o.y = pk2(a[2], a[3]);
            *(v2u*)(ACT + ((size_t)pm * 256 + j) * DFF + f) = o;
        }
    }
    XSYNC();
    {
        pg8::Gemm g{ACT, WT_DN, TOK, 1024, DFF}; pg8::StaticOrder S; S.init(TOK, 1024, G, bx);
        pg8::EpiG5 E{P.out, X1B};
        GEMM_PHASE(pg8::EpiG5);
    }
}

extern "C" void kernel_launch(void* const* d_in, const int* in_sizes, int n_in, void* d_out, int out_size, void* d_ws, size_t ws_size, hipStream_t stream) {
    static int grid = 0;
    if (grid == 0) {
        if (n_in != 17 || in_sizes[0] != TOK * DM || out_size != TOK * DM || ws_size < WS_END) { fprintf(stderr, "kernel_launch: unexpected shapes / workspace (n_in %d, ws %zu)\n", n_in, ws_size); grid = -1; return; }
        int dev = 0, cus = 0, per_cu = 0;
        hipGetDevice(&dev); hipDeviceGetAttribute(&cus, hipDeviceAttributeMultiprocessorCount, dev);
        if (hipFuncSetAttribute((const void*)fwd, hipFuncAttributeMaxDynamicSharedMemorySize, LDS_BYTES) != hipSuccess) { fprintf(stderr, "kernel_launch: hipFuncSetAttribute failed\n"); grid = -1; return; }
        if (hipOccupancyMaxActiveBlocksPerMultiprocessor(&per_cu, (const void*)fwd, 512, LDS_BYTES) != hipSuccess || per_cu < 1) { fprintf(stderr, "kernel_launch: occupancy query says %d\n", per_cu); per_cu = 1; }
        (void)hipGetLastError();
        grid = cus * per_cu;
    }
    if (grid < 0) return;
    if (hipMemsetAsync(d_ws, 0, 16384, stream) != hipSuccess) { fprintf(stderr, "kernel_launch: memset of the barrier words failed\n"); return; }
    Params p{};
    for (int i = 0; i < 17; ++i) p.in[i] = (const float*)d_in[i];
    p.out = (float*)d_out; p.ws = (unsigned char*)d_ws;
    void* args[] = {&p};
    hipError_t e = hipLaunchCooperativeKernel((const void*)fwd, dim3(grid), dim3(512), args, LDS_BYTES, stream);
    if (e != hipSuccess) fprintf(stderr, "cooperative launch failed: %s (grid %d)\n", hipGetErrorString(e), grid);
}
```
